# Optimizing an MI355X kernel written in HIP

```python
import math
import jax, jax.numpy as jnp
from jax import lax
import numpy as np

D_MODEL = 2048
BATCH = 16
SEQ = 2048
DEPTH = 2

MEM_LEN = 256
RET_HEADS = 4
RET_WIDTH = D_MODEL // 4
RET_DV = RET_WIDTH // RET_HEADS
RET_DK = RET_DV
RET_CHUNK = 128
S5_WIDTH = D_MODEL // 4
S5_GROUP = 16
S5_GROUPS = S5_WIDTH // S5_GROUP
S5_STATE = 64
DIFF_WIDTH = D_MODEL // 2
DIFF_HEADS = 8
DIFF_DV = DIFF_WIDTH // DIFF_HEADS
DIFF_DQK = DIFF_DV // 2
Q_BLOCK = 128
REL_BUCKETS = 32
REL_MAX_DIST = 128
X_HEADS = 4
X_HEAD_DIM = 128
X_WIDTH = X_HEADS * X_HEAD_DIM
D_FF = 4 * D_MODEL
EPS = 1e-6

MIX_WIDTH = RET_WIDTH + S5_WIDTH + DIFF_WIDTH
RET_QK_W = RET_HEADS * RET_DK
DIFF_QK_W = DIFF_HEADS * 2 * DIFF_DQK
IN_SIZES = (RET_QK_W, RET_QK_W, RET_WIDTH, RET_WIDTH, S5_WIDTH, DIFF_QK_W, DIFF_QK_W, DIFF_WIDTH)
IN_WIDTH = int(sum(IN_SIZES))
IN_SPLITS = tuple(int(v) for v in np.cumsum(IN_SIZES)[:-1])

kernel_name = 'hybrid_ret_s5_diffattn_block'


def rmsnorm(x, g):
    xf = x.astype(jnp.float32)
    y = xf * lax.rsqrt(jnp.mean(xf * xf, axis=-1, keepdims=True) + EPS)
    return (y * g.astype(jnp.float32)).astype(x.dtype)


def rotate(x, pos):
    half = x.shape[-1] // 2
    inv = 10000.0 ** (-jnp.arange(half, dtype=jnp.float32) / half)
    ang = pos.astype(jnp.float32)[..., None] * inv
    cos = jnp.cos(ang)[:, :, None, :]
    sin = jnp.sin(ang)[:, :, None, :]
    xf = x.astype(jnp.float32)
    x1, x2 = xf[..., :half], xf[..., half:]
    return jnp.concatenate([x1 * cos - x2 * sin, x1 * sin + x2 * cos], axis=-1)


def retention_group(q, k, v, gate, pos):
    B, S = q.shape[:2]
    H, C = RET_HEADS, RET_CHUNK
    n = S // C
    q = rotate(q.reshape(B, S, H, RET_DK), pos)
    k = rotate(k.reshape(B, S, H, RET_DK), pos) * (RET_DK ** -0.5)
    v = v.reshape(B, S, H, RET_DV).astype(jnp.float32)

    def chunks(t):
        return jnp.moveaxis(t.reshape(B, n, C, H, t.shape[-1]), 1, 0)

    log_g = jnp.log(1.0 - 2.0 ** (-5.0 - jnp.arange(H, dtype=jnp.float32)))
    idx = jnp.arange(C, dtype=jnp.float32)
    dist = idx[:, None] - idx[None, :]
    decay = jnp.where(dist >= 0, jnp.exp(jnp.maximum(dist, 0.0)[None] * log_g[:, None, None]), 0.0)
    xi = jnp.exp((idx + 1.0)[:, None] * log_g[None, :])
    zeta = jnp.exp((C - 1.0 - idx)[:, None] * log_g[None, :])
    g_chunk = jnp.exp(C * log_g)

    def step(R, qkv):
        qc, kc, vc = qkv
        inner = jnp.einsum('bchd,bshd->bhcs', qc, kc) * decay
        o = jnp.einsum('bhcs,bshe->bche', inner, vc)
        o = o + jnp.einsum('bchd,bhde->bche', qc * xi[None, :, :, None], R)
        R = g_chunk[None, :, None, None] * R + jnp.einsum('bshd,bshe->bhde', kc * zeta[None, :, :, None], vc)
        return R, o

    R0 = jnp.zeros((B, H, RET_DK, RET_DV), jnp.float32)
    _, o = lax.scan(step, R0, (chunks(q), chunks(k), chunks(v)))
    o = jnp.moveaxis(o, 0, 1).reshape(B, S, H, RET_DV)
    o = o * lax.rsqrt(jnp.mean(o * o, axis=-1, keepdims=True) + EPS)
    return o.reshape(B, S, RET_WIDTH) * jax.nn.silu(gate.astype(jnp.float32))


def _ssm_combine(e1, e2):
    a1r, a1i, b1r, b1i = e1
    a2r, a2i, b2r, b2i = e2
    ar = a1r * a2r - a1i * a2i
    ai = a1r * a2i + a1i * a2r
    br = a2r * b1r - a2i * b1i + b2r
    bi = a2r * b1i + a2i * b1r + b2i
    return (ar, ai, br, bi)


def s5_group(u, lam_re, lam_im, log_dt, b_re, b_im, c_re, c_im, d_skip, w_glu):
    B, S = u.shape[:2]
    G, P = S5_GROUPS, S5_STATE
    uf = u.astype(jnp.float32).reshape(B, S, G, S5_GROUP)
    lr = jnp.minimum(lam_re.astype(jnp.float32), -1e-4)
    li = lam_im.astype(jnp.float32)
    dt = jnp.exp(log_dt.astype(jnp.float32))[:, None]
    mag = jnp.exp(lr * dt)
    ab_re = mag * jnp.cos(li * dt)
    ab_im = mag * jnp.sin(li * dt)
    nr, ni = ab_re - 1.0, ab_im
    den = lr * lr + li * li
    f_re = ((nr * lr + ni * li) / den)[..., None]
    f_im = ((ni * lr - nr * li) / den)[..., None]
    br, bi = b_re.astype(jnp.float32), b_im.astype(jnp.float32)
    bb_re = f_re * br - f_im * bi
    bb_im = f_re * bi + f_im * br
    bu_re = jnp.einsum('bsgh,gph->sbgp', uf, bb_re)
    bu_im = jnp.einsum('bsgh,gph->sbgp', uf, bb_im)
    a_re = jnp.broadcast_to(ab_re, (S, 1, G, P))
    a_im = jnp.broadcast_to(ab_im, (S, 1, G, P))
    _, _, x_re, x_im = lax.associative_scan(_ssm_combine, (a_re, a_im, bu_re, bu_im), axis=0)
    y = (jnp.einsum('sbgp,ghp->bsgh', x_re, c_re.astype(jnp.float32))
         - jnp.einsum('sbgp,ghp->bsgh', x_im, c_im.astype(jnp.float32)))
    y = y.reshape(B, S, S5_WIDTH) + d_skip.astype(jnp.float32) * uf.reshape(B, S, S5_WIDTH)
    g = jax.nn.gelu(y)
    return g * jax.nn.sigmoid(g @ w_glu.astype(jnp.float32))


def t5_bias(qpos, kpos, table):
    n = jnp.maximum(qpos[:, :, None] - kpos[:, None, :], 0)
    max_exact = REL_BUCKETS // 2
    large = max_exact + (jnp.log(jnp.maximum(n, 1).astype(jnp.float32) / max_exact)
                         / math.log(REL_MAX_DIST / max_exact) * (REL_BUCKETS - max_exact)).astype(jnp.int32)
    large = jnp.minimum(large, REL_BUCKETS - 1)
    bucket = jnp.where(n < max_exact, n, large)
    return jnp.moveaxis(table.astype(jnp.float32)[bucket], -1, 1)


def _block_probs(qa, ka, bias, causal, scale):
    s = jnp.einsum('bqhd,bkhd->bhqk', qa, ka).astype(jnp.float32) * scale + bias
    return jax.nn.softmax(jnp.where(causal, s, -jnp.inf), axis=-1)


def diff_group(q, k, v, pos, rel_bias, lam, lam_init, g_subln):
    B, S = q.shape[:2]
    H = DIFF_HEADS
    q = q.reshape(B, S, H, 2, DIFF_DQK)
    k = k.reshape(B, S, H, 2, DIFF_DQK)
    v = v.reshape(B, S, H, DIFF_DV).astype(jnp.float32)
    q1, q2 = q[..., 0, :], q[..., 1, :]
    k1, k2 = k[..., 0, :], k[..., 1, :]
    scale = DIFF_DQK ** -0.5
    outs = []
    for i in range(S // Q_BLOCK):
        q0 = i * Q_BLOCK
        kend = q0 + Q_BLOCK
        bias = t5_bias(pos[:, q0:kend], pos[:, :kend], rel_bias)
        causal = jnp.arange(kend)[None, :] <= (q0 + jnp.arange(Q_BLOCK))[:, None]
        p1 = _block_probs(q1[:, q0:kend], k1[:, :kend], bias, causal, scale)
        p2 = _block_probs(q2[:, q0:kend], k2[:, :kend], bias, causal, scale)
        outs.append(jnp.einsum('bhqk,bkhe->bqhe', p1 - lam * p2, v[:, :kend]))
    o = jnp.concatenate(outs, axis=1)
    o = rmsnorm(o, g_subln) * (1.0 - lam_init)
    return o.reshape(B, S, DIFF_WIDTH)


def cross_attention(h, mem_n, w_q, w_kv, w_o):
    B, S = h.shape[:2]
    M = mem_n.shape[1]
    q = (h @ w_q).reshape(B, S, X_HEADS, X_HEAD_DIM)
    k, v = jnp.split(mem_n @ w_kv, 2, axis=-1)
    k = k.reshape(B, M, X_HEADS, X_HEAD_DIM)
    v = v.reshape(B, M, X_HEADS, X_HEAD_DIM)
    s = jnp.einsum('bshd,bmhd->bhsm', q, k).astype(jnp.float32) * (X_HEAD_DIM ** -0.5)
    p = jax.nn.softmax(s, axis=-1).astype(v.dtype)
    o = jnp.einsum('bhsm,bmhd->bshd', p, v).reshape(B, S, X_WIDTH)
    return o @ w_o


def setup_inputs(seed: int = 0) -> dict:
    key = jax.random.key(seed)
    ks = jax.random.split(key, 32)
    f32 = jnp.float32
    nrm = lambda k, shape, s: jax.random.normal(k, shape, f32) * s
    gain = lambda k, shape: 1.0 + 0.02 * jax.random.normal(k, shape, f32)
    offs = jax.random.randint(ks[2], (BATCH, 1), 0, 4096, dtype=jnp.int32)
    positions = offs + jnp.arange(SEQ, dtype=jnp.int32)[None, :]
    lam_im0 = math.pi * jnp.arange(S5_STATE, dtype=f32)
    return {
        'x': nrm(ks[0], (BATCH, SEQ, D_MODEL), 1.0),
        'mem': nrm(ks[1], (BATCH, MEM_LEN, D_MODEL), 1.0),
        'positions': positions,
        'rel_bias': nrm(ks[3], (REL_BUCKETS, DIFF_HEADS), 0.5),
        'w_in': nrm(ks[4], (DEPTH, D_MODEL, IN_WIDTH), D_MODEL ** -0.5),
        'w_out': nrm(ks[5], (DEPTH, MIX_WIDTH, D_MODEL), MIX_WIDTH ** -0.5),
        'lam_re': -0.5 + nrm(ks[6], (DEPTH, S5_GROUPS, S5_STATE), 0.01),
        'lam_im': lam_im0 + nrm(ks[7], (DEPTH, S5_GROUPS, S5_STATE), 0.01),
        'log_dt': jax.random.uniform(ks[8], (DEPTH, S5_GROUPS), f32, math.log(1e-3), math.log(1e-1)),
        'b_re': nrm(ks[9], (DEPTH, S5_GROUPS, S5_STATE, S5_GROUP), (2 * S5_GROUP) ** -0.5),
        'b_im': nrm(ks[10], (DEPTH, S5_GROUPS, S5_STATE, S5_GROUP), (2 * S5_GROUP) ** -0.5),
        'c_re': nrm(ks[11], (DEPTH, S5_GROUPS, S5_GROUP, S5_STATE), S5_STATE ** -0.5),
        'c_im': nrm(ks[12], (DEPTH, S5_GROUPS, S5_GROUP, S5_STATE), S5_STATE ** -0.5),
        'd_skip': nrm(ks[13], (DEPTH, S5_WIDTH), 1.0),
        'w_glu': nrm(ks[14], (DEPTH, S5_WIDTH, S5_WIDTH), S5_WIDTH ** -0.5),
        'lam_q1': nrm(ks[15], (DEPTH, DIFF_DQK), 0.1),
        'lam_k1': nrm(ks[16], (DEPTH, DIFF_DQK), 0.1),
        'lam_q2': nrm(ks[17], (DEPTH, DIFF_DQK), 0.1),
        'lam_k2': nrm(ks[18], (DEPTH, DIFF_DQK), 0.1),
        'g_subln': gain(ks[19], (DEPTH, DIFF_DV)),
        'w_xq': nrm(ks[20], (DEPTH, D_MODEL, X_WIDTH), D_MODEL ** -0.5),
        'w_xkv': nrm(ks[21], (DEPTH, D_MODEL, 2 * X_WIDTH), D_MODEL ** -0.5),
        'w_xo': nrm(ks[22], (DEPTH, X_WIDTH, D_MODEL), X_WIDTH ** -0.5),
        'w_up': nrm(ks[23], (DEPTH, D_MODEL, D_FF), D_MODEL ** -0.5),
        'w_down': nrm(ks[24], (DEPTH, D_FF, D_MODEL), D_FF ** -0.5),
        'g_mix_pre': gain(ks[25], (DEPTH, D_MODEL)),
        'g_mix_post': gain(ks[26], (DEPTH, D_MODEL)),
        'g_mem': gain(ks[27], (DEPTH, D_MODEL)),
        'g_x_pre': gain(ks[28], (DEPTH, D_MODEL)),
        'g_x_post': gain(ks[29], (DEPTH, D_MODEL)),
        'g_mlp_pre': gain(ks[30], (DEPTH, D_MODEL)),
        'g_mlp_post': gain(ks[31], (DEPTH, D_MODEL)),
    }


def reference(x, mem, positions, rel_bias, w_in, w_out, lam_re, lam_im, log_dt, b_re, b_im,
              c_re, c_im, d_skip, w_glu, lam_q1, lam_k1, lam_q2, lam_k2, g_subln,
              w_xq, w_xkv, w_xo, w_up, w_down, g_mix_pre, g_mix_post, g_mem,
              g_x_pre, g_x_post, g_mlp_pre, g_mlp_post):
    for l in range(DEPTH):
        lam_init = 0.8 - 0.6 * math.exp(-0.3 * l)
        h = rmsnorm(x, g_mix_pre[l])
        proj = h @ w_in[l]
        rq, rk, rv, rg, su, dq, dk, dv = jnp.split(proj, IN_SPLITS, axis=-1)
        y_ret = retention_group(rq, rk, rv, rg, positions)
        y_s5 = s5_group(su, lam_re[l], lam_im[l], log_dt[l], b_re[l], b_im[l],
                        c_re[l], c_im[l], d_skip[l], w_glu[l])
        lam = (jnp.exp(jnp.sum(lam_q1[l].astype(jnp.float32) * lam_k1[l].astype(jnp.float32)))
               - jnp.exp(jnp.sum(lam_q2[l].astype(jnp.float32) * lam_k2[l].astype(jnp.float32)))
               + lam_init)
        y_diff = diff_group(dq, dk, dv, positions, rel_bias, lam, lam_init, g_subln[l])
        mixed = jnp.concatenate([y_ret, y_s5, y_diff], axis=-1).astype(x.dtype) @ w_out[l]
        x = x + rmsnorm(mixed, g_mix_post[l])
        h = rmsnorm(x, g_x_pre[l])
        mem_n = rmsnorm(mem, g_mem[l])
        x = x + rmsnorm(cross_attention(h, mem_n, w_xq[l], w_xkv[l], w_xo[l]), g_x_post[l])
        h = rmsnorm(x, g_mlp_pre[l])
        y = jnp.square(jax.nn.relu(h @ w_up[l])) @ w_down[l]
        x = x + rmsnorm(y, g_mlp_post[l])
    return x
```

```cpp
#include <hip/hip_runtime.h>
#include <cstdio>
#include <cstdint>
namespace pg8 {
#define PG8_LAS __attribute__((address_space(3)))
typedef unsigned short bf16_t;
typedef short bf16x8 __attribute__((ext_vector_type(8)));
typedef float f32x4 __attribute__((ext_vector_type(4)));
typedef unsigned u32x4 __attribute__((ext_vector_type(4)));
constexpr int BM = 256, BK = 64, HALF = 128, HTB = HALF * BK * 2  , STAGE_BYTES = 8 * HTB, NXCD = 8, WGM = 8;

__host__ __device__ __forceinline__ int lds_byte(int r, int c) { const int st = (r >> 4) * 2 + (c >> 5), rr = r & 15, cc = c & 31, ob = rr * 64 + cc * 2; return st * 1024 + (ob ^ (((ob >> 9) & 1) << 5)); }
__host__ __device__ __forceinline__ void stage_rc(int b, int& R, int& C) { const int st = b / 1024, sb = b % 1024, swz = sb ^ (((sb >> 9) & 1) << 5); R = (st >> 1) * 16 + swz / 64; C = (st & 1) * 32 + (swz % 64) / 2; }
__host__ __device__ __forceinline__ int perm32(int rho) { const int n = rho >> 4, i = rho & 15; return 8 * (i >> 2) + 4 * n + (i & 3); }

struct Unit { int pm, pn; };
struct Gemm { const bf16_t* A; const bf16_t* Bt; int M, N, K; };

struct StaticOrder {
    int nM, nN, nwg, G, c, wgm;
    __host__ __device__ void init(int M, int N, int G_, int c_, int wgm_ = WGM) { nM = M / BM; nN = N / BM; nwg = nM * nN; G = G_; c = c_; wgm = wgm_; }
    __host__ __device__ bool next(int i, Unit& u) const {
        const long L = (long)i * G + c; if (L >= nwg) return false;
        int wgid = (int)L; { const int q = nwg / NXCD, r = nwg % NXCD, xcd = wgid % NXCD, off = wgid / NXCD; wgid = (xcd < r ? xcd * (q + 1) : r * (q + 1) + (xcd - r) * q) + off; }
        const int nig = wgm * nN, gid = wgid / nig, fm = gid * wgm, gsz = (nM - fm) < wgm ? (nM - fm) : wgm;
        u.pm = fm + ((wgid % nig) % gsz); u.pn = (wgid % nig) / gsz; return true;
    }
    __device__ __forceinline__ void a_ready(const Unit&) const {}
    __device__ __forceinline__ void done(const Unit&) const {}
};

typedef float cvf32x2_t __attribute__((ext_vector_type(2))); typedef __bf16 cvbf16x2_t __attribute__((ext_vector_type(2)));
__device__ __forceinline__ unsigned cvt_pk_bf16(float lo, float hi) { const cvf32x2_t v = {lo, hi}; const cvbf16x2_t b = __builtin_convertvector(v, cvbf16x2_t); return __builtin_bit_cast(unsigned, b); }
__device__ __forceinline__ float bf_lo(unsigned w) { return __uint_as_float(w << 16); }
__device__ __forceinline__ float bf_hi(unsigned w) { return __uint_as_float(w & 0xffff0000u); }
template <int ACT> struct EpiB {
    static constexpr bool PERM = true, AFTER_DRAIN = false;
    bf16_t* O; int ldc; float scale; const bf16_t* Gp; int ldg; int sc_lo, sc_hi; const float* rs; bf16_t* sec; int sec_lo; int oblk;
    __device__ __forceinline__ void operator()(const f32x4 (&acc)[2][2][4][2], const Unit& u, int wr, int wc, int fr, int fq) const {
        const int row0 = u.pm * BM + wr * 64 + fr; const int col0 = u.pn * BM + wc * 32 + 8 * fq;
        float rsv8[2][4];
#pragma unroll
        for (int ai = 0; ai < 2; ++ai)
#pragma unroll
            for (int m = 0; m < 4; ++m) rsv8[ai][m] = rs ? rs[row0 + ai * HALF + m * 16] : 1.f;
#pragma unroll
        for (int ai = 0; ai < 2; ++ai) {
            u32x4 gwv[4][2];
            if (ACT == 3) {
#pragma unroll
                for (int m = 0; m < 4; ++m)
#pragma unroll
                    for (int bj = 0; bj < 2; ++bj) gwv[m][bj] = *(const u32x4*)(Gp + (size_t)(row0 + ai * HALF + m * 16) * ldg + col0 + bj * HALF); }
#pragma unroll
            for (int m = 0; m < 4; ++m) { const size_t row = (size_t)(row0 + ai * HALF + m * 16); bf16_t* rowp = O + row * ldc + col0; size_t bstep = HALF;
                if (oblk) { rowp = O + ((row >> 4) * (size_t)(ldc / 32) + (col0 >> 5)) * 512 + (row & 15) * 32 + (col0 & 31); bstep = 4 * 512; }
                if (ACT == 0 && sec && u.pn >= sec_lo) { const int t12 = u.pn - sec_lo;
                    rowp = sec + (size_t)(t12 >> 2) * ((size_t)32768 * 1024) + (((row >> 11) * 8 + 2 * (t12 & 3)) * 2048 + (row & 2047)) * 128 + wc * 32 + 8 * fq; bstep = (size_t)2048 * 128; } const float rsv = rsv8[ai][m];
#pragma unroll
                for (int bj = 0; bj < 2; ++bj) { f32x4 v0 = acc[ai][bj][m][0], v1 = acc[ai][bj][m][1];
                    if (ACT == 0) { const float sc = ((u.pn >= sc_lo && u.pn < sc_hi) ? scale : 1.f) * rsv; v0 = v0 * sc; v1 = v1 * sc; }
                    if (ACT == 2) {
#pragma unroll
                        for (int e = 0; e < 4; ++e) { const float a = fmaxf(v0[e] * rsv, 0.f), b = fmaxf(v1[e] * rsv, 0.f); v0[e] = a * a; v1[e] = b * b; } }
                    if (ACT == 3) { const u32x4 gw = gwv[m][bj];
                        const float g0 = bf_lo(gw.x), g1 = bf_hi(gw.x), g2 = bf_lo(gw.y), g3 = bf_hi(gw.y), g4 = bf_lo(gw.z), g5 = bf_hi(gw.z), g6 = bf_lo(gw.w), g7 = bf_hi(gw.w);
                        v0[0] = g0 / (1.f + __expf(-v0[0])); v0[1] = g1 / (1.f + __expf(-v0[1])); v0[2] = g2 / (1.f + __expf(-v0[2])); v0[3] = g3 / (1.f + __expf(-v0[3]));
                        v1[0] = g4 / (1.f + __expf(-v1[0])); v1[1] = g5 / (1.f + __expf(-v1[1])); v1[2] = g6 / (1.f + __expf(-v1[2])); v1[3] = g7 / (1.f + __expf(-v1[3])); }
                    u32x4 w; w.x = cvt_pk_bf16(v0[0], v0[1]); w.y = cvt_pk_bf16(v0[2], v0[3]); w.z = cvt_pk_bf16(v1[0], v1[1]); w.w = cvt_pk_bf16(v1[2], v1[3]);
                    *(u32x4*)(rowp + bj * bstep) = w; } } }
    }
};

template <class Epi, class Sched, bool ALIGN_EPI = false, bool SP2 = false, bool A_BLK = false>
__device__ __forceinline__ void gemm_phase(PG8_LAS unsigned char* lds, const Gemm g, const Sched& S, const Epi& E) {
    int tid_ = threadIdx.x; asm volatile("" : "+v"(tid_));
    const int tid = tid_, wid = __builtin_amdgcn_readfirstlane(tid >> 6), lane = tid & 63, wr = wid >> 2, wc = wid & 3, fr = lane & 15, fq = lane >> 4;
    const int K = g.K, nt = K / BK;
    unsigned voffA[2], voffB[2];
    static_assert(Epi::PERM, "the weight copies are stored in the row order of PERM epilogues");
#pragma unroll
    for (int i = 0; i < 2; ++i) { int R, C; stage_rc(tid * 16 + i * 8192, R, C);
        const unsigned blk = (unsigned)((((R >> 4) * (K / 32) + (C >> 5)) * 512 + (R & 15) * 32 + (C & 31)) * 2);
        voffA[i] = A_BLK ? blk : (unsigned)(R * K + C) * 2u; voffB[i] = blk; }
    const size_t kstepA = A_BLK ? (size_t)2048 : (size_t)(BK * 2), kstepB = 2048;
    const size_t hstep = (size_t)HALF * K * 2;
    const size_t tstep = 2 * hstep;
    const unsigned ldsw = (unsigned)wid * 1024u;
    const int aoff = lds_byte(wr * 64 + fr, fq * 8), boff = lds_byte(wc * 32 + fr, fq * 8);
#define PG8_SA(b, h) (((b) * 2 + (h)) * HTB)
#define PG8_SB(b, h) ((4 + (b) * 2 + (h)) * HTB)
#define PG8_STAGE(bufoff, gbase, voff) do { _Pragma("unroll") for (int _i = 0; _i < 2; ++_i) \
        __builtin_amdgcn_global_load_lds((const unsigned*)((const char*)(gbase) + (voff)[_i]), (PG8_LAS unsigned*)(lds + (bufoff) + ldsw + _i * 8192), 16, 0, 0); } while (0)
#define PG8_LDA(dst, b, h) do { _Pragma("unroll") for (int m = 0; m < 4; ++m) _Pragma("unroll") for (int k = 0; k < 2; ++k) dst[m][k] = *(const PG8_LAS bf16x8*)(lds + PG8_SA(b, h) + aoff + m * 2048 + k * 1024); } while (0)
#define PG8_LDB(dst, b, h) do { _Pragma("unroll") for (int n = 0; n < 2; ++n) _Pragma("unroll") for (int k = 0; k < 2; ++k) dst[n][k] = *(const PG8_LAS bf16x8*)(lds + PG8_SB(b, h) + boff + n * 2048 + k * 1024); } while (0)
#define PG8_MMA(ai, bj, At, Bt) do { __builtin_amdgcn_s_setprio(1); _Pragma("unroll") for (int m = 0; m < 4; ++m) _Pragma("unroll") for (int n = 0; n < 2; ++n) _Pragma("unroll") for (int k = 0; k < 2; ++k) \
        acc[ai][bj][m][n] = __builtin_amdgcn_mfma_f32_16x16x32_bf16(Bt[n][k], At[m][k], acc[ai][bj][m][n], 0, 0, 0); __builtin_amdgcn_s_setprio(0); } while (0)
#define PG8_WAIT_V(n) asm volatile("s_waitcnt vmcnt(" #n ")" ::: "memory")
#define PG8_WAIT_L(n) asm volatile("s_waitcnt lgkmcnt(" #n ")" ::: "memory")
#define PG8_BAR __builtin_amdgcn_s_barrier()
#define PG8_SCHED __builtin_amdgcn_sched_barrier(0)
    Unit cur, nxt; int ui = 0;
    if (!S.next(0, cur)) return;
    f32x4 acc[2][2][4][2];
#pragma unroll
    for (int a = 0; a < 2; ++a)
#pragma unroll
        for (int b = 0; b < 2; ++b)
#pragma unroll
            for (int m = 0; m < 4; ++m)
#pragma unroll
                for (int n = 0; n < 2; ++n) acc[a][b][m][n] = (f32x4){0.f, 0.f, 0.f, 0.f};
    bf16x8 At[4][2], B0[2][2], B1[2][2];
    const char* cA = (const char*)g.A + (size_t)cur.pm * tstep; const char* cB = (const char*)g.Bt + (size_t)cur.pn * tstep;
    S.a_ready(cur);
    if constexpr (SP2) {
        PG8_STAGE(PG8_SB(0, 0), cB, voffB); PG8_STAGE(PG8_SB(0, 1), cB + hstep, voffB); PG8_STAGE(PG8_SA(0, 0), cA, voffA); PG8_STAGE(PG8_SA(0, 1), cA + hstep, voffA);
        if (wr == 1) PG8_BAR;
        PG8_WAIT_V(2); PG8_BAR;
        PG8_STAGE(PG8_SB(1, 0), cB + kstepB, voffB); PG8_STAGE(PG8_SA(1, 0), cA + kstepA, voffA); PG8_STAGE(PG8_SB(1, 1), cB + hstep + kstepB, voffB);
        PG8_WAIT_V(6); PG8_BAR;
    } else {
        PG8_STAGE(PG8_SB(0, 0), cB, voffB); PG8_STAGE(PG8_SA(0, 0), cA, voffA); PG8_STAGE(PG8_SB(0, 1), cB + hstep, voffB); PG8_STAGE(PG8_SA(0, 1), cA + hstep, voffA);
        if (wr == 1) PG8_BAR;
        PG8_WAIT_V(4); PG8_BAR;
        PG8_STAGE(PG8_SB(1, 0), cB + kstepB, voffB); PG8_STAGE(PG8_SA(1, 0), cA + kstepA, voffA); PG8_STAGE(PG8_SB(1, 1), cB + hstep + kstepB, voffB);
        PG8_WAIT_V(6); PG8_BAR;
    }
    for (;;) {
        const bool has_next = S.next(ui + 1, nxt);
        const char* nA = has_next ? (const char*)g.A + (size_t)nxt.pm * tstep : cA; const char* nB = has_next ? (const char*)g.Bt + (size_t)nxt.pn * tstep : cB;
        for (int t = 0; t < nt; t += 2) {
            const bool last = (t == nt - 2);
            const char* a1 = cA + (size_t)(t + 1) * kstepA;
            const char* a2 = last ? nA : cA + (size_t)(t + 2) * kstepA; const char* b2 = last ? nB : cB + (size_t)(t + 2) * kstepB;
            const char* a3 = a2 + kstepA; const char* b3 = b2 + kstepB;
            if (last && has_next) S.a_ready(nxt);
            if constexpr (SP2) {
            PG8_LDB(B0, 0, 0); PG8_LDB(B1, 0, 1); PG8_SCHED; PG8_LDA(At, 0, 0); PG8_STAGE(PG8_SA(1, 1), a1 + hstep, voffA);
            PG8_WAIT_V(8); PG8_WAIT_L(0); PG8_BAR; PG8_MMA(0, 0, At, B0); PG8_MMA(0, 1, At, B1); PG8_BAR; PG8_SCHED;
            PG8_LDA(At, 0, 1); PG8_STAGE(PG8_SB(0, 0), b2, voffB); PG8_STAGE(PG8_SB(0, 1), b2 + hstep, voffB); PG8_STAGE(PG8_SA(0, 0), a2, voffA);
            PG8_WAIT_V(8); PG8_WAIT_L(0); PG8_BAR; PG8_MMA(1, 0, At, B0); PG8_MMA(1, 1, At, B1); PG8_BAR; PG8_SCHED;
            PG8_LDB(B0, 1, 0); PG8_LDB(B1, 1, 1); PG8_SCHED; PG8_LDA(At, 1, 0); PG8_STAGE(PG8_SA(0, 1), a2 + hstep, voffA);
            PG8_WAIT_V(8); PG8_WAIT_L(0); PG8_BAR; PG8_MMA(0, 0, At, B0); PG8_MMA(0, 1, At, B1); PG8_BAR; PG8_SCHED;
            PG8_LDA(At, 1, 1); PG8_STAGE(PG8_SB(1, 0), b3, voffB); PG8_STAGE(PG8_SB(1, 1), b3 + hstep, voffB); PG8_STAGE(PG8_SA(1, 0), a3, voffA);
            PG8_WAIT_V(8); PG8_WAIT_L(0); PG8_BAR; PG8_MMA(1, 0, At, B0); PG8_MMA(1, 1, At, B1); PG8_BAR; PG8_SCHED;
            } else {
            PG8_LDB(B0, 0, 0); PG8_SCHED; PG8_LDA(At, 0, 0); PG8_STAGE(PG8_SA(1, 1), a1 + hstep, voffA);
            PG8_WAIT_L(8); PG8_BAR; PG8_WAIT_L(0); PG8_MMA(0, 0, At, B0); PG8_BAR; PG8_SCHED;
            PG8_LDB(B1, 0, 1); PG8_STAGE(PG8_SB(0, 0), b2, voffB);
            PG8_BAR; PG8_WAIT_L(0); PG8_MMA(0, 1, At, B1); PG8_BAR;
            PG8_LDA(At, 0, 1); PG8_STAGE(PG8_SA(0, 0), a2, voffA);
            PG8_BAR; PG8_WAIT_L(0); PG8_MMA(1, 0, At, B0); PG8_BAR; PG8_SCHED;
            PG8_STAGE(PG8_SB(0, 1), b2 + hstep, voffB);
            PG8_WAIT_V(6); PG8_BAR; PG8_MMA(1, 1, At, B1); PG8_BAR;
            PG8_LDB(B0, 1, 0); PG8_SCHED; PG8_LDA(At, 1, 0); PG8_STAGE(PG8_SA(0, 1), a2 + hstep, voffA);
            PG8_WAIT_L(8); PG8_BAR; PG8_WAIT_L(0); PG8_MMA(0, 0, At, B0); PG8_BAR; PG8_SCHED;
            PG8_LDB(B1, 1, 1); PG8_STAGE(PG8_SB(1, 0), b3, voffB);
            PG8_BAR; PG8_WAIT_L(0); PG8_MMA(0, 1, At, B1); PG8_BAR;
            PG8_LDA(At, 1, 1); PG8_STAGE(PG8_SA(1, 0), a3, voffA);
            PG8_BAR; PG8_WAIT_L(0); PG8_MMA(1, 0, At, B0); PG8_BAR; PG8_SCHED;
            PG8_STAGE(PG8_SB(1, 1), b3 + hstep, voffB);
            PG8_WAIT_V(6); PG8_BAR; PG8_MMA(1, 1, At, B1); PG8_BAR;
            }
        }
        if constexpr (ALIGN_EPI) { if (wr == 0) PG8_BAR; }
        if constexpr (!Epi::AFTER_DRAIN) { E(acc, cur, wr, wc, fr, fq); S.done(cur); }
        if (!has_next) break;
#pragma unroll
        for (int a = 0; a < 2; ++a)
#pragma unroll
            for (int b = 0; b < 2; ++b)
#pragma unroll
                for (int m = 0; m < 4; ++m)
#pragma unroll
                    for (int n = 0; n < 2; ++n) acc[a][b][m][n] = (f32x4){0.f, 0.f, 0.f, 0.f};
        cur = nxt; cA = nA; cB = nB; ++ui;
        if constexpr (ALIGN_EPI) { if (wr == 1) PG8_BAR; }
    }
    PG8_WAIT_V(0);
    if constexpr (!ALIGN_EPI) { if (wr == 0) PG8_BAR; }
    PG8_BAR;
    if constexpr (Epi::AFTER_DRAIN) { E.fused(acc, cur, wr, wc, fr, fq, lds, wid, lane); S.done(cur); }
#undef PG8_SA
#undef PG8_SB
#undef PG8_STAGE
#undef PG8_LDA
#undef PG8_LDB
#undef PG8_MMA
#undef PG8_WAIT_V
#undef PG8_WAIT_L
#undef PG8_BAR
#undef PG8_SCHED
}

}
namespace at16 {
typedef float f32x4 __attribute__((ext_vector_type(4)));
typedef short bf16x8 __attribute__((ext_vector_type(8)));
typedef short s16x4 __attribute__((ext_vector_type(4)));
typedef unsigned u32x4 __attribute__((ext_vector_type(4)));
typedef int i32x4 __attribute__((ext_vector_type(4)));
constexpr int KT_BYTES = 64 * 256, VT_BYTES = 64 * 256;
constexpr int NBUF = 4, OFF_V = NBUF * KT_BYTES, OFF_LUT = OFF_V + NBUF * VT_BYTES, OFF_KPOS = OFF_LUT + 544, OFF_KMAX = OFF_KPOS + 2048 * 4, LDS_NEED = OFF_KMAX + 32 * 4;
constexpr float THR = 8.f;
typedef float cvf32x2_t __attribute__((ext_vector_type(2))); typedef __bf16 cvbf16x2_t __attribute__((ext_vector_type(2)));
__device__ __forceinline__ unsigned cvtpk(float lo, float hi) { const cvf32x2_t v = {lo, hi}; const cvbf16x2_t b = __builtin_convertvector(v, cvbf16x2_t); return __builtin_bit_cast(unsigned, b); }
typedef short v4i16_t __attribute__((ext_vector_type(4)));
__device__ __forceinline__ s16x4 vtr(const __attribute__((address_space(3))) unsigned char* p) { return __builtin_bit_cast(s16x4, __builtin_amdgcn_ds_read_tr16_b64_v4i16((__attribute__((address_space(3))) v4i16_t*)p)); }

struct Unit {
    const unsigned short* Q; int ldq;
    const unsigned short* K; int ldk;
    const unsigned short* V; int ldv;
    int NT;
    const int* posq; const int* posk;
    const float* lut; int lut_stride;
    int q0;
};

template <int NMAP, int KS, bool DIFF>
__device__ __forceinline__ void run(const Unit& U, __attribute__((address_space(3))) unsigned char* lds, f32x4 (&o)[NMAP][8], float (&inv)[NMAP][4]) {
    typedef __attribute__((address_space(3))) unsigned char* lptr;
    int tid_ = threadIdx.x; asm volatile("" : "+v"(tid_));
    const int tid = tid_, lane = tid & 63, wid = __builtin_amdgcn_readfirstlane(tid >> 6), i = lane & 15, g = lane >> 4;
    const unsigned ldsb = (unsigned)(uintptr_t)lds;
    unsigned kvo[2], vvo[2];
#pragma unroll
    for (int j = 0; j < 2; ++j) { const int row = 4 * (wid + 8 * j) + (lane >> 4), p = lane & 15;
        kvo[j] = (unsigned)(row * U.ldk + ((p ^ (row & 15)) * 8)) * 2u; vvo[j] = (unsigned)(row * U.ldv + ((p ^ (2 * (row & 7))) * 8)) * 2u; }
#define AT_DMA(gbase, voff, ldst) do { unsigned keep_; asm volatile("s_mov_b32 %0, m0\n\ts_mov_b32 m0, %3\n\ts_nop 0\n\tglobal_load_lds_dwordx4 %1, %2\n\ts_mov_b32 m0, %0" : "=&s"(keep_) : "v"(voff), "s"(gbase), "s"(ldst) : "memory"); } while (0)
#define AT_LOAD(t, bi) do { const unsigned short* kt_ = U.K + (size_t)(t) * 64 * U.ldk; const unsigned short* vt_ = U.V + (size_t)(t) * 64 * U.ldv; \
        _Pragma("unroll") for (int j_ = 0; j_ < 2; ++j_) { \
            AT_DMA(kt_, kvo[j_], (unsigned)__builtin_amdgcn_readfirstlane(ldsb + (bi) * KT_BYTES + (wid + 8 * j_) * 1024)); \
            AT_DMA(vt_, vvo[j_], (unsigned)__builtin_amdgcn_readfirstlane(ldsb + OFF_V + (bi) * VT_BYTES + (wid + 8 * j_) * 1024)); } } while (0)
    AT_LOAD(0, 0); if (U.NT > 1) AT_LOAD(1, 1);
    bf16x8 qf[NMAP][KS];
    { const unsigned short* qp = U.Q + (size_t)(wid * 16 + i) * U.ldq + 8 * g;
#pragma unroll
      for (int m = 0; m < NMAP; ++m)
#pragma unroll
        for (int ks = 0; ks < KS; ++ks) qf[m][ks] = *(const bf16x8*)(qp + (m * KS + ks) * 32); }
    int posq = 0, minposq = 0; float bias_far = 0.f;
    if (DIFF) {
        const int nk4 = U.NT * 16;
        float lutv = U.lut[(tid < 128 ? tid : 128) * U.lut_stride];
        i32x4 kposv = ((const i32x4*)U.posk)[tid < nk4 ? tid : nk4 - 1];
        posq = U.posq[wid * 16 + i]; bias_far = U.lut[128 * U.lut_stride];
        asm volatile("" : "+v"(lutv), "+v"(kposv), "+v"(posq), "+v"(bias_far));
        if (tid < 129) ((__attribute__((address_space(3))) float*)(lds + OFF_LUT))[tid] = lutv;
        if (tid < nk4) ((__attribute__((address_space(3))) i32x4*)(lds + OFF_KPOS))[tid] = kposv;
        minposq = posq;
#pragma unroll
        for (int k_ = 0; k_ < 4; ++k_) { const int ctrl_ = (k_ == 0) ? 0xB1 : (k_ == 1) ? 0x4E : (k_ == 2) ? 0x124 : 0x128;
            const int t_ = (k_ == 0) ? __builtin_amdgcn_update_dpp(0, minposq, 0xB1, 0xF, 0xF, true) : (k_ == 1) ? __builtin_amdgcn_update_dpp(0, minposq, 0x4E, 0xF, 0xF, true)
                         : (k_ == 2) ? __builtin_amdgcn_update_dpp(0, minposq, 0x124, 0xF, 0xF, true) : __builtin_amdgcn_update_dpp(0, minposq, 0x128, 0xF, 0xF, true);
            (void)ctrl_; minposq = t_ < minposq ? t_ : minposq; }
        minposq = __builtin_amdgcn_readfirstlane(minposq);
    }
#pragma unroll
    for (int m = 0; m < NMAP; ++m)
#pragma unroll
        for (int d = 0; d < 8; ++d) o[m][d] = (f32x4){0.f, 0.f, 0.f, 0.f};
    float mrun[NMAP], lrun[NMAP];
#pragma unroll
    for (int m = 0; m < NMAP; ++m) { mrun[m] = 0.f; lrun[m] = 0.f; }
    asm volatile("s_waitcnt vmcnt(0)" ::: "memory");
    __syncthreads();
    if (DIFF) {
#pragma unroll
        for (int k = 0; k < 4; ++k) { const int tt = 4 * wid + k; if (tt < U.NT) { int mx_ = ((__attribute__((address_space(3))) int*)(lds + OFF_KPOS))[tt * 64 + lane];
#pragma unroll
            for (int k_ = 0; k_ < 4; ++k_) {
                const int t_ = (k_ == 0) ? __builtin_amdgcn_update_dpp(0, mx_, 0xB1, 0xF, 0xF, true) : (k_ == 1) ? __builtin_amdgcn_update_dpp(0, mx_, 0x4E, 0xF, 0xF, true)
                             : (k_ == 2) ? __builtin_amdgcn_update_dpp(0, mx_, 0x124, 0xF, 0xF, true) : __builtin_amdgcn_update_dpp(0, mx_, 0x128, 0xF, 0xF, true);
                mx_ = t_ > mx_ ? t_ : mx_; }
            { auto r16 = __builtin_amdgcn_permlane16_swap((unsigned)mx_, (unsigned)mx_, false, false); const int a_ = (int)r16[0], b_ = (int)r16[1]; mx_ = a_ > b_ ? a_ : b_; }
            { auto r32 = __builtin_amdgcn_permlane32_swap((unsigned)mx_, (unsigned)mx_, false, false); const int a_ = (int)r32[0], b_ = (int)r32[1]; mx_ = a_ > b_ ? a_ : b_; }
            if (lane == 0) ((__attribute__((address_space(3))) int*)(lds + OFF_KMAX))[tt] = mx_; } }
        __syncthreads();
    }
    asm volatile("" : "+v"(bias_far), "+v"(posq));
#pragma unroll
    for (int m = 0; m < NMAP; ++m)
#pragma unroll
        for (int ks = 0; ks < KS; ++ks) asm volatile("" : "+v"(qf[m][ks]));
    const lptr kbase = lds + i * 256;
    const unsigned vlane = 256 * (4 * g + ((lane >> 2) & 3)) + 32 * (4 * (g & 1) + ((lane >> 2) & 3)) + 16 * ((lane & 3) >> 1) + 8 * (lane & 1);
    const int qidx = U.q0 + wid * 16 + i;
    const int grp = wid >> 2;
    bf16x8 pa[NMAP][2];
    f32x4 sh[NMAP][2];
#define AT_TILEWAIT(tt) do { if ((tt) + 2 < U.NT) asm volatile("s_waitcnt vmcnt(4)" ::: "memory"); else asm volatile("s_waitcnt vmcnt(0)" ::: "memory"); } while (0)
    if (grp == 1 && 2 < U.NT) AT_LOAD(2, 2);
#pragma unroll 1
    for (int t = 0; t < U.NT; ++t) {
        const int b = t & 3;
        const bool active = !DIFF || (t * 64 <= U.q0 + wid * 16 + 15);
        if (grp == 0 && t + 2 < U.NT) AT_LOAD(t + 2, (t + 2) & 3);
        if (active) {
            const lptr kb = kbase + b * KT_BYTES;
            f32x4 s[NMAP][4];
            bf16x8 kf[2][4];
#define AT_KLD(st_) do { _Pragma("unroll") for (int blk = 0; blk < 4; ++blk) kf[(st_) & 1][blk] = *(const __attribute__((address_space(3))) bf16x8*)(kb + blk * 4096 + 16 * (((((st_) / KS) * KS * 4) + 4 * ((st_) % KS) + g) ^ i)); } while (0)
            AT_KLD(0);
            {
                bool far = true;
                if (DIFF) {
                    const int kmax = ((__attribute__((address_space(3))) int*)(lds + OFF_KMAX))[t];
                    const bool diag = (t * 64 + 63 > U.q0 + wid * 16);
                    far = (minposq - kmax >= 128) && !diag;
                }
                if (far) {
#pragma unroll
                    for (int m = 0; m < NMAP; ++m) { const float c = (DIFF ? bias_far : 0.f) - mrun[m];
#pragma unroll
                        for (int blk = 0; blk < 4; ++blk) s[m][blk] = (f32x4){c, c, c, c}; }
                } else {
#pragma unroll
                    for (int blk = 0; blk < 4; ++blk) { const i32x4 pk = *(const __attribute__((address_space(3))) i32x4*)(lds + OFF_KPOS + (t * 64 + 16 * blk + 4 * g) * 4);
                        f32x4 bia;
#pragma unroll
                        for (int r = 0; r < 4; ++r) { int n = posq - pk[r]; n = n < 0 ? 0 : (n > 128 ? 128 : n);
                            float bv = ((__attribute__((address_space(3))) float*)(lds + OFF_LUT))[n];
                            if (t * 64 + 16 * blk + 4 * g + r > qidx) bv = -INFINITY;
                            bia[r] = bv; }
#pragma unroll
                        for (int m = 0; m < NMAP; ++m) s[m][blk] = bia - mrun[m]; }
                }
            }
            {
#pragma unroll
                for (int st = 0; st < NMAP * KS; ++st) { const int m = st / KS, ks = st % KS;
                    if (st + 1 < NMAP * KS) AT_KLD(st + 1);
#pragma unroll
                    for (int blk = 0; blk < 4; ++blk) s[m][blk] = __builtin_amdgcn_mfma_f32_16x16x32_bf16(kf[st & 1][blk], qf[m][ks], s[m][blk], 0, 0, 0);
                }
            }
#undef AT_KLD
            float mx[NMAP]; bool grow = (t == 0);
#pragma unroll
            for (int m = 0; m < NMAP; ++m) {
                float a = fmaxf(fmaxf(s[m][0][0], s[m][0][1]), s[m][0][2]), b2 = fmaxf(fmaxf(s[m][0][3], s[m][1][0]), s[m][1][1]);
                a = fmaxf(fmaxf(a, s[m][1][2]), s[m][1][3]); b2 = fmaxf(fmaxf(b2, s[m][2][0]), s[m][2][1]); a = fmaxf(fmaxf(a, s[m][2][2]), s[m][2][3]);
                b2 = fmaxf(fmaxf(b2, s[m][3][0]), s[m][3][1]); a = fmaxf(fmaxf(a, s[m][3][2]), s[m][3][3]); a = fmaxf(a, b2);
                mx[m] = a; grow = grow || (a > THR);
            }
            if (__any(grow)) {
#pragma unroll
                for (int m = 0; m < NMAP; ++m) {
                    { float a = mx[m];
                      { auto r16 = __builtin_amdgcn_permlane16_swap(__float_as_uint(a), __float_as_uint(a), false, false); a = fmaxf(__uint_as_float(r16[0]), __uint_as_float(r16[1])); }
                      { auto r32 = __builtin_amdgcn_permlane32_swap(__float_as_uint(a), __float_as_uint(a), false, false); a = fmaxf(__uint_as_float(r32[0]), __uint_as_float(r32[1])); }
                      mx[m] = a; }
                    const float dl = (t == 0) ? mx[m] : fmaxf(mx[m], 0.f), al = __builtin_amdgcn_exp2f(-dl); mrun[m] += dl; lrun[m] *= al;
#pragma unroll
                    for (int blk = 0; blk < 4; ++blk) s[m][blk] = s[m][blk] - dl;
                    if (t > 0) {
#pragma unroll
                        for (int r = 0; r < 4; ++r) { const float ar = __shfl(al, 4 * g + r);
#pragma unroll
                            for (int d = 0; d < 8; ++d) o[m][d][r] *= ar; } }
                }
            }
#pragma unroll
            for (int m = 0; m < NMAP; ++m) {
#pragma unroll
                for (int blk = 0; blk < 2; ++blk)
#pragma unroll
                    for (int r = 0; r < 4; ++r) s[m][blk][r] = __builtin_amdgcn_exp2f(s[m][blk][r]);
                lrun[m] += (s[m][0][0] + s[m][0][1]) + (s[m][0][2] + s[m][0][3]) + (s[m][1][0] + s[m][1][1]) + (s[m][1][2] + s[m][1][3]);
                { u32x4 w; w.x = cvtpk(s[m][0][0], s[m][0][1]); w.y = cvtpk(s[m][0][2], s[m][0][3]); w.z = cvtpk(s[m][1][0], s[m][1][1]); w.w = cvtpk(s[m][1][2], s[m][1][3]); pa[m][0] = __builtin_bit_cast(bf16x8, w); }
                sh[m][0] = s[m][2]; sh[m][1] = s[m][3];
            }
        }
        if (grp == 1) { AT_TILEWAIT(t); __syncthreads(); }
        if (grp == 1 && t + 3 < U.NT) AT_LOAD(t + 3, (t + 3) & 3);
        if (active) {
            s16x4 vlo[2], vhi[2];
            __builtin_amdgcn_s_setprio(1);
#define AT_VLD1(d, s2) do { const lptr vb_ = lds + OFF_V + b * VT_BYTES + (vlane ^ (32u * (d))); vlo[(d) & 1] = vtr(vb_ + (32 * (s2)) * 256); vhi[(d) & 1] = vtr(vb_ + (32 * (s2) + 16) * 256); } while (0)
            AT_VLD1(0, 0);
#pragma unroll
            for (int d = 0; d < 8; ++d) { if (d + 1 < 8) AT_VLD1(d + 1, 0);
                const bf16x8 vf_ = (bf16x8){vlo[d & 1][0], vlo[d & 1][1], vlo[d & 1][2], vlo[d & 1][3], vhi[d & 1][0], vhi[d & 1][1], vhi[d & 1][2], vhi[d & 1][3]};
#pragma unroll
                for (int m = 0; m < NMAP; ++m) o[m][d] = __builtin_amdgcn_mfma_f32_16x16x32_bf16(pa[m][0], vf_, o[m][d], 0, 0, 0);
#pragma unroll
                for (int m = 0; m < NMAP; ++m) { const int blk = d >> 2, r = d & 3; sh[m][blk][r] = __builtin_amdgcn_exp2f(sh[m][blk][r]); }
            }
#pragma unroll
            for (int m = 0; m < NMAP; ++m) {
                lrun[m] += (sh[m][0][0] + sh[m][0][1]) + (sh[m][0][2] + sh[m][0][3]) + (sh[m][1][0] + sh[m][1][1]) + (sh[m][1][2] + sh[m][1][3]);
                u32x4 w; w.x = cvtpk(sh[m][0][0], sh[m][0][1]); w.y = cvtpk(sh[m][0][2], sh[m][0][3]); w.z = cvtpk(sh[m][1][0], sh[m][1][1]); w.w = cvtpk(sh[m][1][2], sh[m][1][3]); pa[m][1] = __builtin_bit_cast(bf16x8, w);
            }
            AT_VLD1(0, 1);
#pragma unroll
            for (int d = 0; d < 8; ++d) { if (d + 1 < 8) AT_VLD1(d + 1, 1);
                const bf16x8 vf_ = (bf16x8){vlo[d & 1][0], vlo[d & 1][1], vlo[d & 1][2], vlo[d & 1][3], vhi[d & 1][0], vhi[d & 1][1], vhi[d & 1][2], vhi[d & 1][3]};
#pragma unroll
                for (int m = 0; m < NMAP; ++m) o[m][d] = __builtin_amdgcn_mfma_f32_16x16x32_bf16(pa[m][1], vf_, o[m][d], 0, 0, 0);
            }
            __builtin_amdgcn_s_setprio(0);
#undef AT_VLD1
        }
        if (grp == 0) { AT_TILEWAIT(t); __syncthreads(); }
    }
    __syncthreads();
#undef AT_TILEWAIT
#undef AT_LOAD
#undef AT_DMA
#pragma unroll
    for (int m = 0; m < NMAP; ++m) { float lt = lrun[m]; lt += __shfl_xor(lt, 16); lt += __shfl_xor(lt, 32);
#pragma unroll
        for (int r = 0; r < 4; ++r) inv[m][r] = 1.0f / __shfl(lt, 4 * g + r); }
}
}
namespace s5f {
typedef float f32x4 __attribute__((ext_vector_type(4)));
typedef short bf16x8 __attribute__((ext_vector_type(8)));
typedef unsigned u32x4 __attribute__((ext_vector_type(4)));
typedef unsigned u32x2 __attribute__((ext_vector_type(2)));
#define S5_LAS __attribute__((address_space(3)))
constexpr int UB_STR = 1056, XB_STR = 288;
constexpr int OFF_UB = 0, OFF_XB = 64 * UB_STR, OFF_SC = OFF_XB + 64 * XB_STR, OFF_KT = OFF_SC + 64 * 128 * 4, LDS_NEED = OFF_KT + 16384;
constexpr size_t C_KT = 0, C_QM = 1u << 20, C_PM = 5u << 20, C_AL = 9u << 20;

__device__ __forceinline__ void sincos_dd(double ang, double& s, double& c) {
    const double q = __builtin_rint(ang * 0.63661977236758134308);
    double r = __builtin_fma(-q, 1.57079632679489655800, ang); r = __builtin_fma(-q, 6.12323399573676603587e-17, r);
    const int qi = ((int)q) & 3; const double r2 = r * r;
    const double sr = r * (1.0 + r2 * (-1.0 / 6 + r2 * (1.0 / 120 + r2 * (-1.0 / 5040 + r2 * (1.0 / 362880 + r2 * (-1.0 / 39916800 + r2 * (1.0 / 6227020800.0 + r2 * (-1.0 / 1307674368000.0))))))));
    const double cr = 1.0 + r2 * (-0.5 + r2 * (1.0 / 24 + r2 * (-1.0 / 720 + r2 * (1.0 / 40320 + r2 * (-1.0 / 3628800 + r2 * (1.0 / 479001600.0 + r2 * (-1.0 / 87178291200.0 + r2 * (1.0 / 20922789888000.0))))))));
    s = (qi == 0) ? sr : (qi == 1) ? cr : (qi == 2) ? -sr : -cr;
    c = (qi == 0) ? cr : (qi == 1) ? -sr : (qi == 2) ? -cr : sr;
}
struct Basics { double lrdt, th; float fre, fim; };
__device__ __forceinline__ Basics basics(const float* lam_re, const float* lam_im, const float* log_dt, int l, int g, int p) {
    Basics B; const double lr = (double)fminf(lam_re[(l * 32 + g) * 64 + p], -1e-4f), li = (double)lam_im[(l * 32 + g) * 64 + p], dt = exp((double)log_dt[l * 32 + g]);
    B.lrdt = lr * dt; B.th = li * dt;
    double sn, cs; sincos_dd(B.th, sn, cs); const double mag = exp(B.lrdt), nr = mag * cs - 1.0, ni = mag * sn, den = lr * lr + li * li;
    B.fre = (float)((nr * lr + ni * li) / den); B.fim = (float)((ni * lr - nr * li) / den);
    return B;
}
__device__ __forceinline__ void apow(const Basics& B, int n, float& re, float& im) {
    double sn, cs; sincos_dd(B.th * (double)n, sn, cs); const double mag = exp(B.lrdt * (double)n); re = (float)(mag * cs); im = (float)(mag * sn);
}
#define S5_DPP(v, ctrl) __builtin_bit_cast(float, __builtin_amdgcn_update_dpp(0, __builtin_bit_cast(int, (v)), (ctrl), 0xF, 0xF, true))
__device__ __forceinline__ float wsum(float v) {
    v += S5_DPP(v, 0xB1); v += S5_DPP(v, 0x4E); v += S5_DPP(v, 0x124); v += S5_DPP(v, 0x128);
    v += __shfl_xor(v, 16); v += __shfl_xor(v, 32);
    return v;
}
__device__ __forceinline__ unsigned short f2bf_(float f) { unsigned u = __builtin_bit_cast(unsigned, f); return (unsigned short)((u + 0x7fffu + ((u >> 16) & 1u)) >> 16); }

__device__ __forceinline__ void consts(unsigned char* cbase, const float* lam_re, const float* lam_im, const float* log_dt, const float* b_re, const float* b_im, const float* c_re, const float* c_im,
                                       int l, int gw, int NGW, int lane) {
    unsigned short* KT = (unsigned short*)(cbase + C_KT); unsigned short* QM = (unsigned short*)(cbase + C_QM); unsigned short* PM = (unsigned short*)(cbase + C_PM); float* AL = (float*)(cbase + C_AL);
    for (int task = gw; task < 32 * 32; task += NGW) {
        const int g = task >> 5, tau = task & 31, p = lane;
        const Basics B = basics(lam_re, lam_im, log_dt, l, g, p);
        float ar, ai; apow(B, tau, ar, ai);
        float bbr[16], bbi[16];
#pragma unroll
        for (int j = 0; j < 16; ++j) { const float br = b_re[((size_t)(l * 32 + g) * 64 + p) * 16 + j], bi = b_im[((size_t)(l * 32 + g) * 64 + p) * 16 + j]; bbr[j] = B.fre * br - B.fim * bi; bbi[j] = B.fre * bi + B.fim * br; }
        float crv[16], civ[16];
#pragma unroll
        for (int h = 0; h < 16; ++h) { crv[h] = c_re[((size_t)(l * 32 + g) * 16 + h) * 64 + p]; civ[h] = c_im[((size_t)(l * 32 + g) * 16 + h) * 64 + p]; }
#pragma unroll
        for (int h = 0; h < 16; ++h) {
            const float cr = crv[h], ci = civ[h];
            const float car = cr * ar - ci * ai, cai = cr * ai + ci * ar;
            float sel = 0.f;
#pragma unroll
            for (int j = 0; j < 16; ++j) { float v = car * bbr[j] - cai * bbi[j];
                v = wsum(v);
                sel = (lane == j) ? v : sel; }
            if (lane < 16) KT[((size_t)(g * 32 + tau) * 16 + h) * 16 + lane] = f2bf_(sel);
        }
    }
    for (int task = gw * 64 + lane; task < 32 * 32 * 64; task += NGW * 64) {
        const int p = task & 63, n = (task >> 6) & 31, g = task >> 11;
        const Basics B = basics(lam_re, lam_im, log_dt, l, g, p);
        float crv[16], civ[16], brv[16], biv[16];
#pragma unroll
        for (int h = 0; h < 16; ++h) { crv[h] = c_re[((size_t)(l * 32 + g) * 16 + h) * 64 + p]; civ[h] = c_im[((size_t)(l * 32 + g) * 16 + h) * 64 + p]; }
#pragma unroll
        for (int j = 0; j < 16; ++j) { brv[j] = b_re[((size_t)(l * 32 + g) * 64 + p) * 16 + j]; biv[j] = b_im[((size_t)(l * 32 + g) * 64 + p) * 16 + j]; }
        float ar, ai; apow(B, n + 1, ar, ai);
#pragma unroll
        for (int h = 0; h < 16; ++h) { const float cr = crv[h], ci = civ[h];
            QM[((size_t)g * 512 + n * 16 + h) * 128 + p] = f2bf_(cr * ar - ci * ai); QM[((size_t)g * 512 + n * 16 + h) * 128 + 64 + p] = f2bf_(-(cr * ai + ci * ar)); }
        apow(B, 31 - n, ar, ai);
#pragma unroll
        for (int j = 0; j < 16; ++j) { const float br = brv[j], bi = biv[j];
            const float bbr = B.fre * br - B.fim * bi, bbi = B.fre * bi + B.fim * br;
            PM[((size_t)g * 128 + p) * 512 + n * 16 + j] = f2bf_(ar * bbr - ai * bbi); PM[((size_t)g * 128 + 64 + p) * 512 + n * 16 + j] = f2bf_(ar * bbi + ai * bbr); }
        if (n == 0) { apow(B, 32, ar, ai); AL[(g * 64 + p) * 2] = ar; AL[(g * 64 + p) * 2 + 1] = ai; }
    }
}

__device__ __forceinline__ float gelu_tanh(float x) { const float u = 0.7978845608028654f * (x + 0.044715f * x * x * x); const float e = __expf(2.f * u); return 0.5f * x * (2.f - 2.f / (e + 1.f)); }

__device__ __forceinline__ void unit(const unsigned short* proj_su, int ldp, unsigned short* Gout, const unsigned char* cbase, int g, const float* dsk, S5_LAS unsigned char* lds) {
    int tid_ = threadIdx.x; asm volatile("" : "+v"(tid_));
    const int tid = tid_, lane = tid & 63, w = __builtin_amdgcn_readfirstlane(tid >> 6), i = lane & 15, gq = lane >> 4;
    const unsigned short* KTg = (const unsigned short*)(cbase + C_KT) + (size_t)g * 32 * 256;
    const unsigned short* QMg = (const unsigned short*)(cbase + C_QM) + (size_t)g * 512 * 128;
    const unsigned short* PMg = (const unsigned short*)(cbase + C_PM) + (size_t)g * 128 * 512;
    const float* ALg = (const float*)(cbase + C_AL) + g * 128;
    bf16x8 pa[16];
#pragma unroll
    for (int ks = 0; ks < 16; ++ks) pa[ks] = *(const bf16x8*)(PMg + (size_t)(16 * w + i) * 512 + 32 * ks + 8 * gq);
    {
        u32x4 uv[4][2], kv2[2];
#pragma unroll
        for (int k = 0; k < 4; ++k) { const int idx = tid + 512 * k, c = idx >> 5, s = idx & 31; const unsigned short* src = proj_su + (size_t)(c * 32 + s) * ldp; uv[k][0] = *(const u32x4*)src; uv[k][1] = *(const u32x4*)(src + 8); }
#pragma unroll
        for (int k = 0; k < 2; ++k) { const int idx = tid + 512 * k; kv2[k] = *(const u32x4*)(KTg + idx * 8); }
#pragma unroll
        for (int k = 0; k < 4; ++k) { asm volatile("" : "+v"(uv[k][0]), "+v"(uv[k][1])); }
#pragma unroll
        for (int k = 0; k < 2; ++k) { asm volatile("" : "+v"(kv2[k])); }
#pragma unroll
        for (int k = 0; k < 4; ++k) { const int idx = tid + 512 * k, c = idx >> 5, s = idx & 31;
            *(S5_LAS u32x4*)(lds + OFF_UB + c * UB_STR + s * 32) = uv[k][0]; *(S5_LAS u32x4*)(lds + OFF_UB + c * UB_STR + s * 32 + 16) = uv[k][1]; }
#pragma unroll
        for (int k = 0; k < 2; ++k) { const int idx = tid + 512 * k; *(S5_LAS u32x4*)(lds + OFF_KT + idx * 16) = kv2[k]; }
    }
    __syncthreads();
    {
        f32x4 a1[4];
#pragma unroll
        for (int cb = 0; cb < 4; ++cb) a1[cb] = (f32x4){0.f, 0.f, 0.f, 0.f};
#pragma unroll
        for (int ks = 0; ks < 16; ++ks)
#pragma unroll
            for (int cb = 0; cb < 4; ++cb) { const bf16x8 bfr = *(const S5_LAS bf16x8*)(lds + OFF_UB + (16 * cb + i) * UB_STR + 64 * ks + 16 * gq);
                a1[cb] = __builtin_amdgcn_mfma_f32_16x16x32_bf16(pa[ks], bfr, a1[cb], 0, 0, 0); }
#pragma unroll
        for (int cb = 0; cb < 4; ++cb) *(S5_LAS f32x4*)(lds + OFF_SC + ((16 * cb + i) * 128 + 16 * w + 4 * gq) * 4) = a1[cb];
    }
    const int t0 = w, t1 = 15 - w, t2 = 16 + w, t3 = 31 - w;
    bf16x8 qa[4][4];
#pragma unroll
    for (int tt = 0; tt < 4; ++tt) { const int t = (tt == 0) ? t0 : (tt == 1) ? t1 : (tt == 2) ? t2 : t3;
#pragma unroll
        for (int k2 = 0; k2 < 4; ++k2) qa[tt][k2] = *(const bf16x8*)(QMg + (size_t)(t * 16 + i) * 128 + 32 * k2 + 8 * gq); }
    __syncthreads();
    if (w == 0) {
        const float ar = ALg[lane * 2], ai = ALg[lane * 2 + 1]; float xr = 0.f, xi = 0.f;
        float sre[2][8], sim[2][8];
#define S5_SLD(bt, c0) do { _Pragma("unroll") for (int j_ = 0; j_ < 8; ++j_) { sre[bt][j_] = *(const S5_LAS float*)(lds + OFF_SC + (((c0) + j_) * 128 + lane) * 4); sim[bt][j_] = *(const S5_LAS float*)(lds + OFF_SC + (((c0) + j_) * 128 + 64 + lane) * 4); } } while (0)
#define S5_SSTEP(bt, c0) do { _Pragma("unroll") for (int j_ = 0; j_ < 8; ++j_) { const int c_ = (c0) + j_; \
            *(S5_LAS unsigned short*)(lds + OFF_XB + c_ * XB_STR + lane * 2) = f2bf_(xr); *(S5_LAS unsigned short*)(lds + OFF_XB + c_ * XB_STR + 128 + lane * 2) = f2bf_(xi); \
            const float nxr_ = ar * xr - ai * xi + sre[bt][j_], nxi_ = ar * xi + ai * xr + sim[bt][j_]; xr = nxr_; xi = nxi_; } } while (0)
        S5_SLD(0, 0);
#pragma unroll 1
        for (int c0 = 0; c0 < 64; c0 += 16) {
            S5_SLD(1, c0 + 8); S5_SSTEP(0, c0);
            if (c0 + 16 < 64) S5_SLD(0, c0 + 16);
            S5_SSTEP(1, c0 + 8);
        }
#undef S5_SLD
#undef S5_SSTEP
    }
    f32x4 acc[4][4];
#pragma unroll
    for (int tt = 0; tt < 4; ++tt)
#pragma unroll
        for (int cb = 0; cb < 4; ++cb) acc[tt][cb] = (f32x4){0.f, 0.f, 0.f, 0.f};
#pragma unroll 2
    for (int ks = 0; ks < 16; ++ks) {
        if (2 * ks > t3) break;
        bf16x8 bfr[4];
#pragma unroll
        for (int cb = 0; cb < 4; ++cb) bfr[cb] = *(const S5_LAS bf16x8*)(lds + OFF_UB + (16 * cb + i) * UB_STR + 64 * ks + 16 * gq);
        const int s = 2 * ks + (gq >> 1);
#pragma unroll
        for (int tt = 0; tt < 4; ++tt) { const int t = (tt == 0) ? t0 : (tt == 1) ? t1 : (tt == 2) ? t2 : t3;
            if (2 * ks <= t) {
                const int tau = t - s; bf16x8 af = (bf16x8){0, 0, 0, 0, 0, 0, 0, 0};
                if (tau >= 0) af = *(const S5_LAS bf16x8*)(lds + OFF_KT + ((tau * 16 + i) * 16 + 8 * (gq & 1)) * 2);
#pragma unroll
                for (int cb = 0; cb < 4; ++cb) acc[tt][cb] = __builtin_amdgcn_mfma_f32_16x16x32_bf16(af, bfr[cb], acc[tt][cb], 0, 0, 0);
            } }
    }
    __syncthreads();
#pragma unroll
    for (int k2 = 0; k2 < 4; ++k2) {
        bf16x8 bfr[4];
#pragma unroll
        for (int cb = 0; cb < 4; ++cb) bfr[cb] = *(const S5_LAS bf16x8*)(lds + OFF_XB + (16 * cb + i) * XB_STR + 64 * k2 + 16 * gq);
#pragma unroll
        for (int tt = 0; tt < 4; ++tt)
#pragma unroll
            for (int cb = 0; cb < 4; ++cb) acc[tt][cb] = __builtin_amdgcn_mfma_f32_16x16x32_bf16(qa[tt][k2], bfr[cb], acc[tt][cb], 0, 0, 0);
    }
    const f32x4 dv = *(const f32x4*)(dsk + 4 * gq);
#pragma unroll
    for (int tt = 0; tt < 4; ++tt) { const int t = (tt == 0) ? t0 : (tt == 1) ? t1 : (tt == 2) ? t2 : t3;
#pragma unroll
        for (int cb = 0; cb < 4; ++cb) { const int c = 16 * cb + i;
            const u32x2 uw = *(const S5_LAS u32x2*)(lds + OFF_UB + c * UB_STR + (t * 16 + 4 * gq) * 2);
            const float u0 = __uint_as_float(uw.x << 16), u1 = __uint_as_float(uw.x & 0xffff0000u), u2 = __uint_as_float(uw.y << 16), u3 = __uint_as_float(uw.y & 0xffff0000u);
            const float y0 = gelu_tanh(acc[tt][cb][0] + dv[0] * u0), y1 = gelu_tanh(acc[tt][cb][1] + dv[1] * u1), y2 = gelu_tanh(acc[tt][cb][2] + dv[2] * u2), y3 = gelu_tanh(acc[tt][cb][3] + dv[3] * u3);
            u32x2 ow; ow.x = (unsigned)f2bf_(y0) | ((unsigned)f2bf_(y1) << 16); ow.y = (unsigned)f2bf_(y2) | ((unsigned)f2bf_(y3) << 16);
            *(u32x2*)(Gout + (size_t)(c * 32 + t) * 512 + 4 * gq) = ow; } }
    __syncthreads();
}
#undef S5_LAS
}
namespace retf {
typedef float f32x4 __attribute__((ext_vector_type(4)));
typedef float f32x2 __attribute__((ext_vector_type(2)));
typedef short bf16x8 __attribute__((ext_vector_type(8)));
typedef short s16x4 __attribute__((ext_vector_type(4)));
typedef short v4i16_t __attribute__((ext_vector_type(4)));
typedef unsigned u32x4 __attribute__((ext_vector_type(4)));
#define RT_LAS __attribute__((address_space(3)))
constexpr int STR = 288, OFF_KP = 0, OFF_VP = 128 * STR, OFF_RP = 256 * STR, LDS_NEED = 384 * STR;
typedef float cvf32x2_t __attribute__((ext_vector_type(2))); typedef __bf16 cvbf16x2_t __attribute__((ext_vector_type(2)));
__device__ __forceinline__ unsigned cvtpk(float lo, float hi) { const cvf32x2_t v = {lo, hi}; const cvbf16x2_t b = __builtin_convertvector(v, cvbf16x2_t); return __builtin_bit_cast(unsigned, b); }
__device__ __forceinline__ s16x4 vtr(const RT_LAS unsigned char* p) { return __builtin_bit_cast(s16x4, __builtin_amdgcn_ds_read_tr16_b64_v4i16((RT_LAS v4i16_t*)p)); }
__device__ __forceinline__ float blo(unsigned w) { return __uint_as_float(w << 16); }
__device__ __forceinline__ float bhi(unsigned w) { return __uint_as_float(w & 0xffff0000u); }
__device__ __forceinline__ unsigned short f2bf_(float f) { unsigned u = __builtin_bit_cast(unsigned, f); return (unsigned short)((u + 0x7fffu + ((u >> 16) & 1u)) >> 16); }
__device__ __forceinline__ void rot8(const u32x4 a, const u32x4 b, const f32x2* cs, float sc, u32x4& r1, u32x4& r2) {
    float x1[8] = {blo(a.x), bhi(a.x), blo(a.y), bhi(a.y), blo(a.z), bhi(a.z), blo(a.w), bhi(a.w)}, x2[8] = {blo(b.x), bhi(b.x), blo(b.y), bhi(b.y), blo(b.z), bhi(b.z), blo(b.w), bhi(b.w)};
    float o1[8], o2[8];
#pragma unroll
    for (int j = 0; j < 8; ++j) { o1[j] = (x1[j] * cs[j].x - x2[j] * cs[j].y) * sc; o2[j] = (x1[j] * cs[j].y + x2[j] * cs[j].x) * sc; }
    r1.x = cvtpk(o1[0], o1[1]); r1.y = cvtpk(o1[2], o1[3]); r1.z = cvtpk(o1[4], o1[5]); r1.w = cvtpk(o1[6], o1[7]);
    r2.x = cvtpk(o2[0], o2[1]); r2.y = cvtpk(o2[2], o2[3]); r2.z = cvtpk(o2[4], o2[5]); r2.w = cvtpk(o2[6], o2[7]);
}
__device__ __forceinline__ void unit(const unsigned short* pq, const unsigned short* pk, const unsigned short* pv, const unsigned short* pg, int ldp, const f32x2* rot, unsigned short* out, int ldo, int h, float eps, RT_LAS unsigned char* lds) {
    int tid_ = threadIdx.x; asm volatile("" : "+v"(tid_));
    const int tid = tid_, lane = tid & 63, w = __builtin_amdgcn_readfirstlane(tid >> 6), i = lane & 15, g = lane >> 4, q4 = (lane >> 2) & 3, p4 = lane & 3;
    const float gam = 1.f - exp2f(-5.f - (float)h), lg2 = log2f(gam), gC1 = exp2f(127.f * lg2);
    f32x4 Racc[8];
#pragma unroll
    for (int d = 0; d < 8; ++d) Racc[d] = (f32x4){0.f, 0.f, 0.f, 0.f};
    const RT_LAS unsigned char* trb = lds + q4 * STR + 8 * p4;
#pragma unroll 1
    for (int n = 0; n < 16; ++n) {
        u32x4 ka[2], kb[2], va[4], qa_[2], qb_[2]; f32x4 kr[2][4], qr[2][4];
#pragma unroll
        for (int k = 0; k < 2; ++k) { const int idx = tid + 512 * k, s_ = idx >> 3, c = idx & 7; const size_t row = (size_t)(n * 128 + s_);
            ka[k] = *(const u32x4*)(pk + row * ldp + 8 * c); kb[k] = *(const u32x4*)(pk + row * ldp + 64 + 8 * c);
            const f32x4* rp = (const f32x4*)(rot + row * 64 + 8 * c);
#pragma unroll
            for (int j = 0; j < 4; ++j) kr[k][j] = rp[j]; }
#pragma unroll
        for (int k = 0; k < 4; ++k) { const int idx = tid + 512 * k, s_ = idx >> 4, c = idx & 15; va[k] = *(const u32x4*)(pv + (size_t)(n * 128 + s_) * ldp + 8 * c); }
        { const size_t row = (size_t)(n * 128 + 16 * w + i);
#pragma unroll
          for (int ks = 0; ks < 2; ++ks) { qa_[ks] = *(const u32x4*)(pq + row * ldp + 32 * ks + 8 * g); qb_[ks] = *(const u32x4*)(pq + row * ldp + 64 + 32 * ks + 8 * g);
              const f32x4* rp = (const f32x4*)(rot + row * 64 + 32 * ks + 8 * g);
#pragma unroll
              for (int j = 0; j < 4; ++j) qr[ks][j] = rp[j]; } }
#pragma unroll
        for (int k = 0; k < 2; ++k) { const int idx = tid + 512 * k, s_ = idx >> 3, c = idx & 7;
            f32x2 cs[8];
#pragma unroll
            for (int j = 0; j < 4; ++j) { const f32x4 t4 = kr[k][j]; cs[2 * j] = (f32x2){t4.x, t4.y}; cs[2 * j + 1] = (f32x2){t4.z, t4.w}; }
            u32x4 r1, r2; rot8(ka[k], kb[k], cs, 0.08838834764831845f * exp2f(-(float)s_ * lg2), r1, r2);
            *(RT_LAS u32x4*)(lds + OFF_KP + s_ * STR + 16 * c) = r1; *(RT_LAS u32x4*)(lds + OFF_KP + s_ * STR + 128 + 16 * c) = r2; }
#pragma unroll
        for (int k = 0; k < 4; ++k) { const int idx = tid + 512 * k, s_ = idx >> 4, c = idx & 15; *(RT_LAS u32x4*)(lds + OFF_VP + s_ * STR + 16 * c) = va[k]; }
        bf16x8 qf[4];
        { const float qsc = exp2f((float)(16 * w + i) * lg2);
#pragma unroll
          for (int ks = 0; ks < 2; ++ks) {
              f32x2 cs[8];
#pragma unroll
              for (int j = 0; j < 4; ++j) { const f32x4 t4 = qr[ks][j]; cs[2 * j] = (f32x2){t4.x, t4.y}; cs[2 * j + 1] = (f32x2){t4.z, t4.w}; }
              u32x4 r1, r2; rot8(qa_[ks], qb_[ks], cs, qsc, r1, r2); qf[ks] = __builtin_bit_cast(bf16x8, r1); qf[ks + 2] = __builtin_bit_cast(bf16x8, r2); } }
        __syncthreads();
        f32x4 O[8];
#pragma unroll
        for (int d = 0; d < 8; ++d) O[d] = (f32x4){0.f, 0.f, 0.f, 0.f};
        if (n > 0) {
            {
                s16x4 xlo[4], xhi[4];
#define RT_XLD(st_, sl_) do { xlo[sl_] = vtr(trb + OFF_RP + (32 * ((st_) >> 3) + 8 * g) * STR + 32 * ((st_) & 7)); xhi[sl_] = vtr(trb + OFF_RP + (32 * ((st_) >> 3) + 8 * g + 4) * STR + 32 * ((st_) & 7)); } while (0)
#pragma unroll
                for (int p = 0; p < 4; ++p) RT_XLD(p, p);
#pragma unroll
                for (int st = 0; st < 32; ++st) { const s16x4 lo = xlo[st & 3], hi = xhi[st & 3];
                    const bf16x8 rf = (bf16x8){lo[0], lo[1], lo[2], lo[3], hi[0], hi[1], hi[2], hi[3]};
                    if (st + 4 < 32) RT_XLD(st + 4, st & 3);
                    O[st & 7] = __builtin_amdgcn_mfma_f32_16x16x32_bf16(qf[st >> 3], rf, O[st & 7], 0, 0, 0); }
#undef RT_XLD
            }
#pragma unroll
            for (int d = 0; d < 8; ++d) O[d] = O[d] * gam;
        }
        bf16x8 pa[4];
        {
            f32x4 s[8];
#pragma unroll
            for (int blk = 0; blk < 8; ++blk) { s[blk] = (f32x4){0.f, 0.f, 0.f, 0.f};
                if (blk <= w) {
#pragma unroll
                    for (int ks = 0; ks < 4; ++ks) { const bf16x8 kf = *(const RT_LAS bf16x8*)(lds + OFF_KP + (16 * blk + i) * STR + 64 * ks + 16 * g);
                        s[blk] = __builtin_amdgcn_mfma_f32_16x16x32_bf16(kf, qf[ks], s[blk], 0, 0, 0); }
                    if (blk == w) {
#pragma unroll
                        for (int r = 0; r < 4; ++r) if (4 * g + r > i) s[blk][r] = 0.f;
                    }
                } }
#pragma unroll
            for (int s2 = 0; s2 < 4; ++s2) { u32x4 wv; wv.x = cvtpk(s[2 * s2][0], s[2 * s2][1]); wv.y = cvtpk(s[2 * s2][2], s[2 * s2][3]); wv.z = cvtpk(s[2 * s2 + 1][0], s[2 * s2 + 1][1]); wv.w = cvtpk(s[2 * s2 + 1][2], s[2 * s2 + 1][3]);
                pa[s2] = __builtin_bit_cast(bf16x8, wv); }
        }
#pragma unroll
        for (int s2 = 0; s2 < 4; ++s2)
            if (2 * s2 <= w) {
                s16x4 plo[4], phi[4];
#define RT_PLD(d_, sl_) do { plo[sl_] = vtr(trb + OFF_VP + (32 * s2 + 4 * g) * STR + 32 * (d_)); phi[sl_] = vtr(trb + OFF_VP + (32 * s2 + 16 + 4 * g) * STR + 32 * (d_)); } while (0)
#pragma unroll
                for (int p = 0; p < 4; ++p) RT_PLD(p, p);
#pragma unroll
                for (int d = 0; d < 8; ++d) { const s16x4 lo = plo[d & 3], hi = phi[d & 3];
                    const bf16x8 vf = (bf16x8){lo[0], lo[1], lo[2], lo[3], hi[0], hi[1], hi[2], hi[3]};
                    if (d + 4 < 8) RT_PLD(d + 4, d & 3);
                    O[d] = __builtin_amdgcn_mfma_f32_16x16x32_bf16(pa[s2], vf, O[d], 0, 0, 0); }
#undef RT_PLD
            }
        {
            float ss[4] = {0.f, 0.f, 0.f, 0.f};
#pragma unroll
            for (int d = 0; d < 8; ++d)
#pragma unroll
                for (int r = 0; r < 4; ++r) ss[r] += O[d][r] * O[d][r];
            unsigned short gtv[4][8];
#pragma unroll
            for (int r = 0; r < 4; ++r) { const size_t row = (size_t)(n * 128 + 16 * w + 4 * g + r);
#pragma unroll
                for (int d = 0; d < 8; ++d) gtv[r][d] = pg[row * ldp + 16 * d + i]; }
#pragma unroll
            for (int r = 0; r < 4; ++r) {
                { float v_ = ss[r];
                  v_ += __builtin_bit_cast(float, __builtin_amdgcn_update_dpp(0, __builtin_bit_cast(int, v_), 0xB1, 0xF, 0xF, true)); v_ += __builtin_bit_cast(float, __builtin_amdgcn_update_dpp(0, __builtin_bit_cast(int, v_), 0x4E, 0xF, 0xF, true));
                  v_ += __builtin_bit_cast(float, __builtin_amdgcn_update_dpp(0, __builtin_bit_cast(int, v_), 0x124, 0xF, 0xF, true)); v_ += __builtin_bit_cast(float, __builtin_amdgcn_update_dpp(0, __builtin_bit_cast(int, v_), 0x128, 0xF, 0xF, true));
                  ss[r] = v_; } }
#pragma unroll
            for (int r = 0; r < 4; ++r)
#pragma unroll
                for (int d = 0; d < 8; ++d) asm volatile("" : "+v"(gtv[r][d]));
#pragma unroll
            for (int r = 0; r < 4; ++r) {
                const float rs = 1.0f / sqrtf(ss[r] * (1.f / 128.f) + eps);
                const size_t row = (size_t)(n * 128 + 16 * w + 4 * g + r);
#pragma unroll
                for (int d = 0; d < 8; ++d) { const float gt = __uint_as_float((unsigned)gtv[r][d] << 16);
                    out[row * ldo + 16 * d + i] = f2bf_(O[d][r] * rs * (gt / (1.f + __expf(-gt)))); }
            }
        }
        if (n < 15) {
#pragma unroll
            for (int d = 0; d < 8; ++d) Racc[d] = Racc[d] * gam;
            {
                bf16x8 kt[4];
#pragma unroll
                for (int ks = 0; ks < 4; ++ks) { const s16x4 klo = vtr(trb + OFF_KP + (32 * ks + 8 * g) * STR + 32 * w), khi = vtr(trb + OFF_KP + (32 * ks + 8 * g + 4) * STR + 32 * w);
                    kt[ks] = (bf16x8){klo[0], klo[1], klo[2], klo[3], khi[0], khi[1], khi[2], khi[3]}; }
                s16x4 ulo[4], uhi[4];
#define RT_ULD(st_, sl_) do { ulo[sl_] = vtr(trb + OFF_VP + (32 * ((st_) >> 3) + 8 * g) * STR + 32 * ((st_) & 7)); uhi[sl_] = vtr(trb + OFF_VP + (32 * ((st_) >> 3) + 8 * g + 4) * STR + 32 * ((st_) & 7)); } while (0)
#pragma unroll
                for (int p = 0; p < 4; ++p) RT_ULD(p, p);
#pragma unroll
                for (int st = 0; st < 32; ++st) { const s16x4 lo = ulo[st & 3], hi = uhi[st & 3];
                    const bf16x8 vf = (bf16x8){lo[0], lo[1], lo[2], lo[3], hi[0], hi[1], hi[2], hi[3]};
                    if (st + 4 < 32) RT_ULD(st + 4, st & 3);
                    Racc[st & 7] = __builtin_amdgcn_mfma_f32_16x16x32_bf16(kt[st >> 3], vf, Racc[st & 7], 0, 0, 0); }
#undef RT_ULD
            }
#pragma unroll
            for (int d = 0; d < 8; ++d) Racc[d] = Racc[d] * gC1;
        }
        __syncthreads();
        if (n < 15) {
#pragma unroll
            for (int d = 0; d < 8; ++d)
#pragma unroll
                for (int r = 0; r < 4; ++r) *(RT_LAS unsigned short*)(lds + OFF_RP + (16 * w + 4 * g + r) * STR + (16 * d + i) * 2) = f2bf_(Racc[d][r]);
        }
    }
    __syncthreads();
}
#undef RT_LAS
}

#ifndef PG8_SP2
#define PG8_SP2 true
#endif
#ifndef PG8_ALIGN
#define PG8_ALIGN true
#endif
constexpr int NWAVES = 8;
#ifndef MK_ONE_LAUNCH
#define MK_ONE_LAUNCH 1
#endif

constexpr int BATCH = 16, SEQ = 2048, DM = 2048, T = BATCH * SEQ, DEPTH = 2, MEMLEN = 256, TMEM = BATCH * MEMLEN;
constexpr int INW = 5632, INWP = 2560, DFF = 8192, XW = 512;
constexpr int C_RQ = 0, C_RK = 512, C_RV = 1024, C_RG = 1536, C_SU = 2048, C_DQ = 2560, C_DK = 3584, C_DV = 4608;
constexpr int RET_H = 4, S5_G = 32, S5_P = 64, DIFF_H = 8, X_H = 4;
constexpr float EPS = 1e-6f;
#ifndef MLP_SPLIT
#define MLP_SPLIT 4
#endif
constexpr int MLP_ROWS = T / MLP_SPLIT;
constexpr int NPH_LAYER = 11 + MLP_SPLIT, NPHASES = 1 + DEPTH * NPH_LAYER;

constexpr size_t MiB = 1u << 20;
constexpr size_t WS_CTL = 0, CTL_ZERO_BYTES = 1 * MiB;
constexpr size_t WS_TAB = 1 * MiB;
constexpr size_t WS_ROT = 2 * MiB;
constexpr size_t WS_MEMN = 18 * MiB;
constexpr size_t WS_KVX = 34 * MiB;
constexpr size_t WS_S5C = 42 * MiB;
constexpr size_t WS_WIN = 66 * MiB, WS_WOUT = 88 * MiB, WS_WGLU = 96 * MiB, WS_WXQ = 97 * MiB, WS_WXKV = 99 * MiB, WS_WXO = 103 * MiB, WS_WUP = 105 * MiB, WS_WDN = 137 * MiB;
constexpr size_t WS_XB = 169 * MiB;
constexpr size_t WS_RS = 1 * MiB + 65536, WS_RSM = 1 * MiB + 65536 + 262144;
constexpr size_t WS_WL1 = 231 * MiB;
constexpr size_t WS_Y = (617 + 128) * MiB;
constexpr size_t WS_MIXED = 425 * MiB;
constexpr size_t WS_G = 553 * MiB;
constexpr size_t WS_QX = 585 * MiB;
constexpr size_t WS_PROJ = 617 * MiB;
constexpr size_t WS_DSEC = WS_PROJ + 160 * MiB;
constexpr size_t WS_END = 969 * MiB;
static_assert(WS_PROJ + (size_t)T * INW * 2 <= WS_END && (size_t)(T / 4) * DFF * 2 <= (size_t)T * INW * 2 && (size_t)T * INWP * 2 == 160 * MiB, "d_ws map");
constexpr int CW_TMO = 0, CW_CODE = 1;
constexpr int CW_BAR = 4096;
constexpr int CW_QUEUE = 16384;

constexpr int RING_OFF = 0, RING_BYTES = 131072;
constexpr int LDSCTL_OFF = 162816, MISC_OFF = LDSCTL_OFF + 320;
constexpr int LDS_BYTES = 163840;
static_assert(MISC_OFF + 128 <= LDS_BYTES, "LDS map");

#define GAS __attribute__((address_space(1)))
#define LAS __attribute__((address_space(3)))
typedef unsigned short bf16;
typedef unsigned v4u __attribute__((ext_vector_type(4)));
typedef unsigned v2u __attribute__((ext_vector_type(2)));
typedef float f32x4 __attribute__((ext_vector_type(4)));
typedef float f32x2 __attribute__((ext_vector_type(2)));
typedef short bf16x8 __attribute__((ext_vector_type(8)));
typedef GAS unsigned gu32;
typedef GAS unsigned long long gu64;
#define RLX_AGENT __ATOMIC_RELAXED, __HIP_MEMORY_SCOPE_AGENT
#define LDS_WAIT() asm volatile("s_waitcnt lgkmcnt(0)" ::: "memory")
#define VM_WAIT() asm volatile("s_waitcnt vmcnt(0)" ::: "memory")
__device__ __forceinline__ unsigned f2bf(float f) { unsigned u = __builtin_bit_cast(unsigned, f); return (u + 0x7fffu + ((u >> 16) & 1u)) >> 16; }
__device__ __forceinline__ unsigned pk2(float lo, float hi) { return f2bf(lo) | (f2bf(hi) << 16); }
__device__ __forceinline__ float bf2f(bf16 b) { return __uint_as_float((unsigned)b << 16); }
__device__ __forceinline__ float bflo(unsigned w) { return __uint_as_float(w << 16); }
__device__ __forceinline__ float bfhi(unsigned w) { return __uint_as_float(w & 0xffff0000u); }

#define XB_TMO      128
#define XB_XCNT(j)  (256  + 64 * (j))
#define XB_XSUB(j)  (1280 + 64 * (j))
#define XB_XGEN(j)  (2304 + 64 * (j))
#define XB_TOP      3328
#define XB_TOPGEN   3392
#define XCD_BAR_WORDS 3456
#define XB_SPIN_CAP (1u << 21)

__device__ __forceinline__ unsigned xb_ld(unsigned* p)              { return __hip_atomic_load(p, __ATOMIC_RELAXED, __HIP_MEMORY_SCOPE_AGENT); }
__device__ __forceinline__ unsigned xb_add(unsigned* p, unsigned v) { return __hip_atomic_fetch_add(p, v, __ATOMIC_RELAXED, __HIP_MEMORY_SCOPE_AGENT); }
__device__ __forceinline__ unsigned xb_xcc_id() { return (unsigned)__builtin_amdgcn_s_getreg((3 << 11) | 20) & 0xFu; }
#define XB_SPIN(cond, bar) do { unsigned _sp = 0; while (cond) { __builtin_amdgcn_s_sleep(1); \
    if ((++_sp & 255u) == 0u) { if (xb_ld(&(bar)[XB_TMO])) break; if (_sp > XB_SPIN_CAP) { atomicAdd(&(bar)[XB_TMO], 1u); break; } } } } while (0)

struct XcdBarrier {
    unsigned* bar; unsigned x;
    volatile LAS unsigned* st;
};

__device__ __forceinline__ XcdBarrier xcd_barrier_post(unsigned* bar, volatile LAS unsigned* st) {
    XcdBarrier b; b.bar = bar; b.x = xb_xcc_id(); b.st = st;
    if (threadIdx.x == 0) (void)xb_add(&bar[XB_XCNT(b.x)], 1u);
    return b;
}
__device__ __forceinline__ void xcd_barrier_complete(unsigned* bar, unsigned x, unsigned& nloc, unsigned& nx) {
    const unsigned G = gridDim.x * gridDim.y * gridDim.z;
    unsigned sum, cnt, mine, sp = 0u;
    for (;;) {
        sum = 0u; cnt = 0u; mine = 0u;
#pragma unroll
        for (unsigned j = 0; j < 16; ++j) { const unsigned c = xb_ld(&bar[XB_XCNT(j)]); sum += c; cnt += (c > 0u) ? 1u : 0u; mine = (j == x) ? c : mine; }
        if (sum == G) break;
        __builtin_amdgcn_s_sleep(1);
        if ((++sp & 255u) == 0u) { if (xb_ld(&bar[XB_TMO])) break; if (sp > XB_SPIN_CAP) { atomicAdd(&bar[XB_TMO], 1u); break; } }
    }
    nloc = mine > 0u ? mine : 1u; nx = cnt > 0u ? cnt : 1u;
}

__device__ __forceinline__ void xcd_barrier(const XcdBarrier& b) {
    asm volatile("s_waitcnt vmcnt(0)" ::: "memory");
    __syncthreads();
    if (threadIdx.x == 0) {
        unsigned* bar = b.bar;
        __builtin_amdgcn_s_waitcnt(0);
        unsigned nloc = b.st[0], nx = b.st[1];
        if (nloc == 0u) { xcd_barrier_complete(bar, b.x, nloc, nx); b.st[0] = nloc; b.st[1] = nx; }
        const unsigned old = xb_add(&bar[XB_XSUB(b.x)], 1u);
        const unsigned gen = old / nloc;
        if (old + 1u == (gen + 1u) * nloc) {
            __builtin_amdgcn_fence(__ATOMIC_RELEASE, "agent");
            asm volatile("s_waitcnt vmcnt(0)" ::: "memory");
            const unsigned og = xb_add(&bar[XB_TOP], 1u);
            const unsigned tg = og / nx;
            if (og + 1u == (tg + 1u) * nx) xb_add(&bar[XB_TOPGEN], 1u);
            else XB_SPIN(xb_ld(&bar[XB_TOPGEN]) == tg, bar);
            __builtin_amdgcn_fence(__ATOMIC_ACQUIRE, "agent");
            xb_add(&bar[XB_XGEN(b.x)], 1u);
            asm volatile("s_waitcnt vmcnt(0)" ::: "memory");
        } else {
            XB_SPIN(xb_ld(&bar[XB_XGEN(b.x)]) == gen, bar);
            __builtin_amdgcn_fence(__ATOMIC_ACQUIRE, "agent");
            asm volatile("s_waitcnt vmcnt(0)" ::: "memory");
        }
    }
    __syncthreads();
}


struct Frame {
    LAS unsigned char* lds;
    volatile LAS unsigned* MISC;
    gu32* ctl;
    int tid, lane, wave;
    int vcu, G;
    float* out; unsigned char* ws;
};
struct Args { const float* in[32]; float* out; unsigned char* ws; int ph_lo, ph_hi, use_bar, pad; };
#define FIN(i) (A.in[i])
enum { I_X = 0, I_MEM, I_POS, I_RELB, I_WIN, I_WOUT, I_LAMRE, I_LAMIM, I_LOGDT, I_BRE, I_BIM, I_CRE, I_CIM, I_DSKIP, I_WGLU, I_LQ1, I_LK1, I_LQ2, I_LK2, I_GSUB,
       I_WXQ, I_WXKV, I_WXO, I_WUP, I_WDN, I_GMIXPRE, I_GMIXPOST, I_GMEM, I_GXPRE, I_GXPOST, I_GMLPPRE, I_GMLPPOST };

__device__ __forceinline__ int launder_s(int v) { asm volatile("" : "+s"(v)); return v; }
#define WS_DPP(v, ctrl) __builtin_bit_cast(float, __builtin_amdgcn_update_dpp(0, __builtin_bit_cast(int, (v)), (ctrl), 0xF, 0xF, true))
__device__ __forceinline__ float wave_sum(float v) {
    v += WS_DPP(v, 0xB1);
    v += WS_DPP(v, 0x4E);
    v += WS_DPP(v, 0x124);
    v += WS_DPP(v, 0x128);
    v += __shfl_xor(v, 16); v += __shfl_xor(v, 32);
    return v;
}
__device__ __forceinline__ float wave_max(float v) {
#pragma unroll
    for (int o = 1; o < 64; o <<= 1) v = fmaxf(v, __shfl_xor(v, o));
    return v;
}
__device__ __forceinline__ void sincos_acc(double ang, float& s, float& c) {
    const double q = __builtin_rint(ang * 0.63661977236758134308);
    const float r = (float)__builtin_fma(-q, 1.57079632679489661923, ang);
    const int qi = ((int)q) & 3;
    const float r2 = r * r;
    const float sr = r * (1.f + r2 * (-1.6666667e-1f + r2 * (8.3333333e-3f + r2 * (-1.9841270e-4f + r2 * 2.7557319e-6f))));
    const float cr = 1.f + r2 * (-0.5f + r2 * (4.1666667e-2f + r2 * (-1.3888889e-3f + r2 * (2.4801587e-5f + r2 * (-2.7557319e-7f)))));
    s = (qi == 0) ? sr : (qi == 1) ? cr : (qi == 2) ? -sr : -cr;
    c = (qi == 0) ? cr : (qi == 1) ? -sr : (qi == 2) ? -cr : sr;
}

constexpr int TR_PITCH = 68, TR_BYTES = 64 * TR_PITCH * 4;
__device__ __forceinline__ void transpose_item(const float* W, const float* gain, int K, int N, bf16* WT, LAS float* scr, int item, int lane) {
    const int nblk = N / 64, kb = item / nblk, nb = item % nblk, k0 = 64 * kb, n0 = 64 * nb;
    const int kr = lane >> 4, nc = 4 * (lane & 15);
    f32x4 v[16];
#pragma unroll
    for (int i = 0; i < 16; ++i) v[i] = *(const GAS f32x4*)(W + (size_t)(k0 + 4 * i + kr) * N + n0 + nc);
    float gg[16];
#pragma unroll
    for (int i = 0; i < 16; ++i) gg[i] = gain ? gain[k0 + 4 * i + kr] : 1.f;
#pragma unroll
    for (int i = 0; i < 16; ++i) asm volatile("" : "+v"(gg[i]));
#pragma unroll
    for (int i = 0; i < 16; ++i) *(LAS f32x4*)(scr + (4 * i + kr) * TR_PITCH + nc) = v[i] * gg[i];
    LDS_WAIT(); asm volatile("" ::: "memory");
#pragma unroll
    for (int j = 0; j < 8; ++j) { const int idx = lane + 64 * j, n = idx >> 3, c = idx & 7; const LAS float* s = scr + (8 * c) * TR_PITCH + n;
        v4u o; o.x = pk2(s[0 * TR_PITCH], s[1 * TR_PITCH]); o.y = pk2(s[2 * TR_PITCH], s[3 * TR_PITCH]); o.z = pk2(s[4 * TR_PITCH], s[5 * TR_PITCH]); o.w = pk2(s[6 * TR_PITCH], s[7 * TR_PITCH]);
        const int nn = n0 + n, x = nn & 31, rho = (nn & ~31) + ((x >> 2) & 1) * 16 + ((x >> 3) << 2) + (x & 3), kk = k0 + 8 * c;
        *(GAS v4u*)(WT + ((size_t)((rho >> 4) * (K / 32) + (kk >> 5)) * 512 + (rho & 15) * 32 + (kk & 31))) = o; }
    LDS_WAIT(); asm volatile("" ::: "memory");
}
__device__ __forceinline__ void convert_weights(Frame& F, const Args& A, int l, int gw, int NGW, int part_lo, int part_hi) {
    LAS float* scr = (LAS float*)(F.lds + RING_OFF + F.wave * TR_BYTES);
    constexpr int I_IN = (DM / 64) * (INW / 64), I_OUT = (DM / 64) * (DM / 64), I_GLU = (512 / 64) * (512 / 64), I_XQ = (DM / 64) * (XW / 64), I_XKV = (DM / 64) * (2 * XW / 64),
                  I_XO = (XW / 64) * (DM / 64), I_UP = (DM / 64) * (DFF / 64), I_DN = (DFF / 64) * (DM / 64);
    constexpr int NITEMS = I_IN + I_OUT + I_GLU + I_XQ + I_XKV + I_XO + I_UP + I_DN;
    unsigned char* ws = F.ws + (size_t)l * WS_WL1;
    constexpr int I_HEAD = I_IN + I_OUT + I_GLU + I_XQ + I_XKV + I_XO;
    const int it_lo = part_lo == 0 ? 0 : I_HEAD, it_hi = part_hi == 0 ? I_HEAD : NITEMS;
    for (int it = it_lo + gw; it < it_hi; it += NGW) {
        int r = it;
        if (r < I_IN) { transpose_item(A.in[I_WIN] + (size_t)l * DM * INW, A.in[I_GMIXPRE] + l * DM, DM, INW, (bf16*)(ws + WS_WIN), scr, r, F.lane); continue; } r -= I_IN;
        if (r < I_OUT) { transpose_item(A.in[I_WOUT] + (size_t)l * DM * DM, nullptr, DM, DM, (bf16*)(ws + WS_WOUT), scr, r, F.lane); continue; } r -= I_OUT;
        if (r < I_GLU) { transpose_item(A.in[I_WGLU] + (size_t)l * 512 * 512, nullptr, 512, 512, (bf16*)(ws + WS_WGLU), scr, r, F.lane); continue; } r -= I_GLU;
        if (r < I_XQ) { transpose_item(A.in[I_WXQ] + (size_t)l * DM * XW, A.in[I_GXPRE] + l * DM, DM, XW, (bf16*)(ws + WS_WXQ), scr, r, F.lane); continue; } r -= I_XQ;
        if (r < I_XKV) { transpose_item(A.in[I_WXKV] + (size_t)l * DM * 2 * XW, A.in[I_GMEM] + l * DM, DM, 2 * XW, (bf16*)(ws + WS_WXKV), scr, r, F.lane); continue; } r -= I_XKV;
        if (r < I_XO) { transpose_item(A.in[I_WXO] + (size_t)l * XW * DM, nullptr, XW, DM, (bf16*)(ws + WS_WXO), scr, r, F.lane); continue; } r -= I_XO;
        if (r < I_UP) { transpose_item(A.in[I_WUP] + (size_t)l * DM * DFF, A.in[I_GMLPPRE] + l * DM, DM, DFF, (bf16*)(ws + WS_WUP), scr, r, F.lane); continue; } r -= I_UP;
        transpose_item(A.in[I_WDN] + (size_t)l * DFF * DM, nullptr, DFF, DM, (bf16*)(ws + WS_WDN), scr, r, F.lane);
    }
}
__device__ __forceinline__ void row_finish(const float (&v)[4][8], bf16* xo, float* rs, float* fo, int lane) {
    float s2 = 0.f;
#pragma unroll
    for (int j = 0; j < 4; ++j)
#pragma unroll
        for (int e = 0; e < 8; ++e) s2 += v[j][e] * v[j][e];
    if (rs) { const float r = 1.0f / sqrtf(wave_sum(s2) * (1.f / DM) + EPS); if (lane == 0) *rs = r; }
    if (xo) { GAS v4u* o = (GAS v4u*)xo + lane;
#pragma unroll
        for (int j = 0; j < 4; ++j) { v4u w; w.x = pk2(v[j][0], v[j][1]); w.y = pk2(v[j][2], v[j][3]); w.z = pk2(v[j][4], v[j][5]); w.w = pk2(v[j][6], v[j][7]); o[64 * j] = w; } }
    if (fo) { GAS f32x4* o = (GAS f32x4*)fo + 2 * lane;
#pragma unroll
        for (int j = 0; j < 4; ++j) { o[128 * j] = (f32x4){v[j][0], v[j][1], v[j][2], v[j][3]}; o[128 * j + 1] = (f32x4){v[j][4], v[j][5], v[j][6], v[j][7]}; } }
}
__device__ __forceinline__ void unpack8(const v4u w, float (&o)[8]) { o[0] = bflo(w.x); o[1] = bfhi(w.x); o[2] = bflo(w.y); o[3] = bfhi(w.y); o[4] = bflo(w.z); o[5] = bfhi(w.z); o[6] = bflo(w.w); o[7] = bfhi(w.w); }
constexpr int RB = 2;
template <int RB>
__device__ __forceinline__ void resnorm_rows(const bf16* xrow0, const bf16* yrow0, size_t rstep, const f32x4 (&gv)[8], bf16* xo0, float* rs0, float* fo0, size_t rs_step, int lane) {
    v4u xw[RB][4], yw[RB][4];
#pragma unroll
    for (int r = 0; r < RB; ++r) { const GAS v4u* xr = (const GAS v4u*)(xrow0 + r * rstep) + lane; const GAS v4u* yr = (const GAS v4u*)(yrow0 + r * rstep) + lane;
#pragma unroll
        for (int j = 0; j < 4; ++j) { xw[r][j] = xr[64 * j]; yw[r][j] = yr[64 * j]; } }
#pragma unroll
    for (int r = 0; r < RB; ++r) {
        float v[4][8], y[4][8]; float s = 0.f;
#pragma unroll
        for (int j = 0; j < 4; ++j) { unpack8(xw[r][j], v[j]); unpack8(yw[r][j], y[j]);
#pragma unroll
            for (int e = 0; e < 8; ++e) s += y[j][e] * y[j][e]; }
        const float ry = 1.0f / sqrtf(wave_sum(s) * (1.f / DM) + EPS);
#pragma unroll
        for (int j = 0; j < 4; ++j) { const f32x4 g0 = gv[2 * j], g1 = gv[2 * j + 1];
            v[j][0] += y[j][0] * ry * g0.x; v[j][1] += y[j][1] * ry * g0.y; v[j][2] += y[j][2] * ry * g0.z; v[j][3] += y[j][3] * ry * g0.w;
            v[j][4] += y[j][4] * ry * g1.x; v[j][5] += y[j][5] * ry * g1.y; v[j][6] += y[j][6] * ry * g1.z; v[j][7] += y[j][7] * ry * g1.w; }
        row_finish(v, xo0 ? xo0 + r * rstep : nullptr, rs0 ? rs0 + r * rs_step : nullptr, fo0 ? fo0 + r * rstep : nullptr, lane);
    }
}
template <int RB>
__device__ __forceinline__ void f32rows_to_bf(const float* xrow0, size_t rstep, bf16* xo0, float* rs0, size_t rs_step, int lane) {
    f32x4 xw[RB][8];
#pragma unroll
    for (int r = 0; r < RB; ++r) { const GAS f32x4* xr = (const GAS f32x4*)(xrow0 + r * rstep) + 2 * lane;
#pragma unroll
        for (int j = 0; j < 4; ++j) { xw[r][2 * j] = xr[128 * j]; xw[r][2 * j + 1] = xr[128 * j + 1]; } }
#pragma unroll
    for (int r = 0; r < RB; ++r) { float v[4][8];
#pragma unroll
        for (int j = 0; j < 4; ++j) { const f32x4 a = xw[r][2 * j], b = xw[r][2 * j + 1]; v[j][0] = a.x; v[j][1] = a.y; v[j][2] = a.z; v[j][3] = a.w; v[j][4] = b.x; v[j][5] = b.y; v[j][6] = b.z; v[j][7] = b.w; }
        row_finish(v, xo0 + r * rstep, rs0 + r * rs_step, nullptr, lane); }
}
__device__ __forceinline__ void resnorm_phase(Frame& F, const bf16* XBin, const bf16* Y, const float* gpost, bf16* XBout, float* RS, float* fout) {
    const int gw = F.vcu * NWAVES + F.wave, NGW = F.G * NWAVES;
    f32x4 gv[8];
    { const GAS f32x4* gr = (const GAS f32x4*)gpost + 2 * F.lane;
#pragma unroll
      for (int j = 0; j < 4; ++j) { gv[2 * j] = gr[128 * j]; gv[2 * j + 1] = gr[128 * j + 1]; } }
    static_assert(T % RB == 0, "rows per step");
    int m = gw;
    for (; m + (RB - 1) * NGW < T; m += RB * NGW)
        resnorm_rows<RB>(XBin + (size_t)m * DM, Y + (size_t)m * DM, (size_t)NGW * DM, gv, XBout ? XBout + (size_t)m * DM : nullptr, RS ? RS + m : nullptr, fout ? fout + (size_t)m * DM : nullptr, (size_t)NGW, F.lane);
    for (; m < T; m += NGW)
        resnorm_rows<1>(XBin + (size_t)m * DM, Y + (size_t)m * DM, 0, gv, XBout ? XBout + (size_t)m * DM : nullptr, RS ? RS + m : nullptr, fout ? fout + (size_t)m * DM : nullptr, 0, F.lane);
}
__device__ __forceinline__ void prologue_misc(Frame& F, const Args& A) {
    const int gt = (F.vcu * NWAVES + F.wave) * 64 + F.lane, NGT = F.G * NWAVES * 64;
    const int* pos = (const int*)A.in[I_POS];
    GAS f32x2* rot = (GAS f32x2*)(F.ws + WS_ROT);
    for (int i0 = gt; i0 < T * 64; i0 += 8 * NGT) {
        int pv[8];
#pragma unroll
        for (int k = 0; k < 8; ++k) { const int i = i0 + k * NGT; pv[k] = (i < T * 64) ? pos[i >> 6] : 0; }
#pragma unroll
        for (int k = 0; k < 8; ++k) { const int i = i0 + k * NGT;
            if (i < T * 64) { const int d = i & 63;
                const float inv = exp2f(-(float)d * (13.287712379549449f / 64.f));
                const float ang = (float)pv[k] * inv;
                float s, c; sincos_acc((double)ang, s, c);
                rot[i] = (f32x2){c, s}; } }
    }
    GAS float* lut = (GAS float*)(F.ws + WS_TAB);
    for (int i = gt; i < 129 * 8; i += NGT) {
        const int n = i >> 3, h = i & 7;
        int bucket;
        if (n < 16) bucket = n;
        else { const int lg = 16 + (int)(logf((float)n / 16.f) / 2.0794415416798357f * 16.f); bucket = lg < 31 ? lg : 31; }
        lut[i] = A.in[I_RELB][bucket * 8 + h] * 1.4426950408889634f;
    }
    const int gw = F.vcu * NWAVES + F.wave, NGW = F.G * NWAVES;
    { int m = gw; for (; m + (RB - 1) * NGW < TMEM; m += RB * NGW) f32rows_to_bf<RB>(A.in[I_MEM] + (size_t)m * DM, (size_t)NGW * DM, (bf16*)(F.ws + WS_MEMN) + (size_t)m * DM, (float*)(F.ws + WS_RSM) + m, (size_t)NGW, F.lane);
      for (; m < TMEM; m += NGW) f32rows_to_bf<1>(A.in[I_MEM] + (size_t)m * DM, 0, (bf16*)(F.ws + WS_MEMN) + (size_t)m * DM, (float*)(F.ws + WS_RSM) + m, 0, F.lane); }
    { int m = gw; for (; m + (RB - 1) * NGW < T; m += RB * NGW) f32rows_to_bf<RB>(A.in[I_X] + (size_t)m * DM, (size_t)NGW * DM, (bf16*)(F.ws + WS_XB) + (size_t)m * DM, (float*)(F.ws + WS_RS) + m, (size_t)NGW, F.lane);
      for (; m < T; m += NGW) f32rows_to_bf<1>(A.in[I_X] + (size_t)m * DM, 0, (bf16*)(F.ws + WS_XB) + (size_t)m * DM, (float*)(F.ws + WS_RS) + m, 0, F.lane); }
}

__device__ __forceinline__ float silu_f(float x) { return x / (1.f + __expf(-x)); }
__device__ __forceinline__ float diff_lambda(Frame& F, const Args& A, int l, float lam_init) {
    const int d = F.lane;
    const float a = wave_sum(A.in[I_LQ1][l * 64 + d] * A.in[I_LK1][l * 64 + d]), b = wave_sum(A.in[I_LQ2][l * 64 + d] * A.in[I_LK2][l * 64 + d]);
    return expf(a) - expf(b) + lam_init;
}
__device__ __forceinline__ void diff_phase(Frame& F, const Args& A, int l, int qslot) {
    const bf16* proj = (const bf16*)(F.ws + WS_PROJ); bf16* mixed = (bf16*)(F.ws + WS_MIXED);
    const float* lut = (const float*)(F.ws + WS_TAB); const int* pos = (const int*)A.in[I_POS];
    const float lam_init = 0.8f - 0.6f * expf(-0.3f * (float)l);
    const float lam = diff_lambda(F, A, l, lam_init);
    volatile LAS int* slot = (volatile LAS int*)(F.MISC + 16);
    const int xcd = (int)(xb_xcc_id() & 7u);
    for (int kq = 0; kq < 8; ++kq) {
      const int yq = (xcd + kq) & 7;
      gu32* qhead = F.ctl + CW_QUEUE + 64 * (qslot * 8 + yq);
      unsigned nextu = 0;
      if (threadIdx.x == 0) nextu = __hip_atomic_fetch_add(qhead, 1u, RLX_AGENT);
      for (;;) {
        if (threadIdx.x == 0) *slot = (int)nextu;
        __syncthreads();
        const int u = __builtin_amdgcn_readfirstlane(*slot);
        __syncthreads();
        if (u >= 16 * 16) break;
        if (threadIdx.x == 0) nextu = __hip_atomic_fetch_add(qhead, 1u, RLX_AGENT);
        const int qb = 15 - (u >> 4), bh = yq * 16 + (u & 15), b = bh >> 3, h = bh & 7;
        at16::Unit U;
        const bf16* dsec = (const bf16*)(F.ws + WS_DSEC) + (size_t)(b * 8 + h) * SEQ * 128;
        U.Q = dsec + (size_t)(qb * 128) * 128; U.ldq = 128;
        U.K = dsec + (size_t)T * 1024; U.ldk = 128;
        U.V = dsec + 2 * (size_t)T * 1024; U.ldv = 128;
        U.NT = 2 * (qb + 1); U.posq = pos + b * SEQ + qb * 128; U.posk = pos + b * SEQ; U.lut = lut + h; U.lut_stride = 8; U.q0 = qb * 128;
        at16::f32x4 o[2][8]; float inv[2][4];
        float gs[8];
        { int tg_ = threadIdx.x; asm volatile("" : "+v"(tg_));
#pragma unroll
          for (int d = 0; d < 8; ++d) gs[d] = A.in[I_GSUB][l * 128 + 16 * d + (tg_ & 15)]; }
        at16::run<2, 2, true>(U, F.lds + RING_OFF, o, inv);
        int te_ = threadIdx.x; asm volatile("" : "+v"(te_));
        const int i = te_ & 15, g = (te_ >> 4) & 3, wv = __builtin_amdgcn_readfirstlane(te_ >> 6);
        float ss[4] = {0.f, 0.f, 0.f, 0.f};
#pragma unroll
        for (int d = 0; d < 8; ++d) gs[d] *= (1.f - lam_init);
#pragma unroll
        for (int d = 0; d < 8; ++d)
#pragma unroll
            for (int r = 0; r < 4; ++r) { const float v = o[0][d][r] * inv[0][r] - lam * (o[1][d][r] * inv[1][r]); o[0][d][r] = v; ss[r] += v * v; }
        LAS unsigned char* ob = F.lds + RING_OFF;
#pragma unroll
        for (int r = 0; r < 4; ++r) {
            { float v_ = ss[r]; v_ += WS_DPP(v_, 0xB1); v_ += WS_DPP(v_, 0x4E); v_ += WS_DPP(v_, 0x124); v_ += WS_DPP(v_, 0x128); ss[r] = v_; }
            const float sc = 1.0f / sqrtf(ss[r] * (1.f / 128.f) + EPS);
#pragma unroll
            for (int d = 0; d < 8; ++d) *(LAS bf16*)(ob + (wv * 16 + 4 * g + r) * 272 + (16 * d + i) * 2) = (bf16)f2bf(o[0][d][r] * sc * gs[d]);
        }
        __syncthreads();
#pragma unroll
        for (int k = 0; k < 4; ++k) { const int idx = te_ + 512 * k, row = idx >> 4, c = idx & 15;
            *(GAS v4u*)(mixed + (size_t)(b * SEQ + qb * 128 + row) * DM + 1024 + h * 128 + c * 8) = *(const LAS v4u*)(ob + row * 272 + c * 16); }
      }
    }
}
__device__ __forceinline__ void xattn_phase(Frame& F, bf16* obuf) {
    bf16* qx = (bf16*)(F.ws + WS_QX); const bf16* kv = (const bf16*)(F.ws + WS_KVX);
    for (int u = F.vcu; u < BATCH * X_H * 16; u += F.G) {
        const int qb = u & 15, h = (u >> 4) & 3, b = u >> 6;
        at16::Unit U;
        U.Q = qx + (size_t)(b * SEQ + qb * 128) * XW + h * 128; U.ldq = XW;
        U.K = kv + (size_t)(b * MEMLEN) * 1024 + h * 128; U.ldk = 1024;
        U.V = kv + (size_t)(b * MEMLEN) * 1024 + 512 + h * 128; U.ldv = 1024;
        U.NT = MEMLEN / 64; U.posq = nullptr; U.posk = nullptr; U.lut = nullptr; U.lut_stride = 0; U.q0 = 0;
        at16::f32x4 o[1][8]; float inv[1][4];
        at16::run<1, 4, false>(U, F.lds + RING_OFF, o, inv);
        int te_ = threadIdx.x; asm volatile("" : "+v"(te_));
        const int i = te_ & 15, g = (te_ >> 4) & 3, wv = __builtin_amdgcn_readfirstlane(te_ >> 6);
#pragma unroll
        for (int r = 0; r < 4; ++r) { bf16* orow = obuf + (size_t)(b * SEQ + qb * 128 + wv * 16 + 4 * g + r) * XW + h * 128 + i;
#pragma unroll
            for (int d = 0; d < 8; ++d) orow[16 * d] = (bf16)f2bf(o[0][d][r] * inv[0][r]); }
    }
}


__device__ __forceinline__ void s5_phase(Frame& F, const Args& A, int l) {
    static_assert(s5f::LDS_NEED <= LDSCTL_OFF, "S5 LDS");
    const bf16* proj = (const bf16*)(F.ws + WS_PROJ); bf16* Gb = (bf16*)(F.ws + WS_G);
    for (int u = F.vcu; u < BATCH * S5_G; u += F.G) {
        int g = u & 31, b = u >> 5;
        if (F.G == 256) { const int jj = (F.vcu & 31) + 32 * (u >> 8); g = 4 * (F.vcu >> 5) + (jj >> 4); b = jj & 15; }
        s5f::unit(proj + (size_t)(b * SEQ) * INWP + C_SU + g * 16, INWP, Gb + (size_t)(b * SEQ) * 512 + g * 16, F.ws + WS_S5C + (size_t)l * (12 * MiB), g, A.in[I_DSKIP] + l * 512 + g * 16, F.lds + RING_OFF);
    }
}
__device__ __forceinline__ void s5_consts_phase(Frame& F, const Args& A, int l) {
    s5f::consts(F.ws + WS_S5C + (size_t)l * (12 * MiB), A.in[I_LAMRE], A.in[I_LAMIM], A.in[I_LOGDT], A.in[I_BRE], A.in[I_BIM], A.in[I_CRE], A.in[I_CIM], l, F.vcu * NWAVES + F.wave, F.G * NWAVES, F.lane);
}


__device__ __forceinline__ void ret_phase(Frame& F) {
    static_assert(retf::LDS_NEED <= LDSCTL_OFF, "retention LDS");
    const bf16* proj = (const bf16*)(F.ws + WS_PROJ); bf16* mixed = (bf16*)(F.ws + WS_MIXED);
    const retf::f32x2* rot = (const retf::f32x2*)(F.ws + WS_ROT);
    const int stride = (F.G >= 256) ? 4 : 1;
    for (int v = F.vcu; v < BATCH * RET_H * stride; v += F.G) {
        if (v % stride) continue;
        const int u = v / stride, h = u & 3, b = u >> 2; const size_t r0 = (size_t)b * SEQ;
        retf::unit(proj + r0 * INWP + C_RQ + h * 128, proj + r0 * INWP + C_RK + h * 128, proj + r0 * INWP + C_RV + h * 128, proj + r0 * INWP + C_RG + h * 128, INWP,
                   rot + r0 * 64, mixed + r0 * DM + h * 128, DM, h, EPS, F.lds + RING_OFF);
    }
}

__global__ void __launch_bounds__(NWAVES * 64, 2) hybrid_fwd(Args A) {
    extern __shared__ __attribute__((aligned(16))) unsigned char lds[];
    Frame F;
    F.lds = (LAS unsigned char*)lds;
    F.MISC = (volatile LAS unsigned*)(F.lds + MISC_OFF);
    F.tid = threadIdx.x; F.lane = F.tid & 63; F.wave = __builtin_amdgcn_readfirstlane(F.tid >> 6);
    F.G = gridDim.x; { const int bx = blockIdx.x; F.vcu = (F.G % 8 == 0) ? (bx % 8) * (F.G / 8) + bx / 8 : bx; }
    unsigned char* ws = A.ws; F.ws = ws; F.out = A.out;
    F.ctl = (gu32*)(ws + WS_CTL);
    for (int u = F.tid; u < (LDS_BYTES - LDSCTL_OFF) / 4; u += NWAVES * 64) ((LAS unsigned*)(F.lds + LDSCTL_OFF))[u] = 0u;
    __syncthreads();
    XcdBarrier bar; bar.bar = (unsigned*)(F.ctl + CW_BAR); bar.x = 0; bar.st = nullptr;
    if (A.use_bar) bar = xcd_barrier_post((unsigned*)(F.ctl + CW_BAR), F.MISC + 8);
    const int lo = A.ph_lo, hi = A.ph_hi;
#ifndef PHMASK
#define PHMASK 0xffff
#endif
#define PHON(k) (((PHMASK) >> (k)) & 1)
#ifndef PHREP
#define PHREP 0
#endif
#define NREP(k) ((((PHREP) >> (k)) & 1) ? 2 : 1)
#define REPLOOP(k) _Pragma("unroll 1") for (int rep = 0; rep < NREP(k); ++rep)
#define REPLAST(k) (rep == NREP(k) - 1)
#define IN(k) (lo <= (k) && (k) < hi)
#define RELAUNDER() do { int t_ = threadIdx.x; asm volatile("" : "+v"(t_)); F.tid = t_; F.lane = t_ & 63; F.wave = __builtin_amdgcn_readfirstlane(t_ >> 6); asm volatile("" : "+s"(F.vcu)); } while (0)
#ifndef SEAM_REP
#define SEAM_REP 1
#endif
#define SEAM(k) do { if (IN((k) + 1)) { _Pragma("unroll 1") for (int sr_ = 0; sr_ < SEAM_REP; ++sr_) xcd_barrier(bar); } } while (0)

    bf16* const XB = (bf16*)(ws + WS_XB); float* const RS = (float*)(ws + WS_RS); bf16* const Yb = (bf16*)(ws + WS_Y); bf16* const PROJ = (bf16*)(ws + WS_PROJ); bf16* const MIXED = (bf16*)(ws + WS_MIXED);
    bf16* const Gb = (bf16*)(ws + WS_G); bf16* const QX = (bf16*)(ws + WS_QX); bf16* const KVX = (bf16*)(ws + WS_KVX); bf16* const MEMN = (bf16*)(ws + WS_MEMN); bf16* const HID = PROJ;

    if (PHON(15) && IN(0)) { RELAUNDER();
        REPLOOP(15) {
        convert_weights(F, A, 0, F.vcu * NWAVES + F.wave, F.G * NWAVES, 0, 1);
#pragma unroll 1
        for (int ll = 0; ll < DEPTH; ++ll) s5_consts_phase(F, A, ll);
        prologue_misc(F, A);
        }
        SEAM(0);
    }
#pragma unroll 1
    for (int l = 0; l < DEPTH; ++l) {
        const int pb = 1 + l * NPH_LAYER;
        unsigned char* const wl = ws + (size_t)l * WS_WL1;
        if (PHON(0) && IN(pb + 0)) { RELAUNDER();
            REPLOOP(0) {
            pg8::Gemm g{XB, (const bf16*)(wl + WS_WIN), T, INW, DM}; pg8::StaticOrder S; S.init(T, INW, F.G, launder_s((int)blockIdx.x));
            pg8::EpiB<0> E{PROJ, INWP, 0.18033688011112042f, nullptr, 0, C_DQ / 256, C_DK / 256, RS, (bf16*)(ws + WS_DSEC), C_DQ / 256, 0};
            pg8::gemm_phase<pg8::EpiB<0>, pg8::StaticOrder, PG8_ALIGN, PG8_SP2>(F.lds + RING_OFF, g, S, E);
            }
            SEAM(pb + 0);
        }
        if (PHON(1) && IN(pb + 1)) { RELAUNDER();
            REPLOOP(16) { pg8::Gemm g{MEMN, (const bf16*)(wl + WS_WXKV), TMEM, 2 * XW, DM}; pg8::StaticOrder S; S.init(TMEM, 2 * XW, F.G, launder_s((int)blockIdx.x));
              pg8::EpiB<0> E{KVX, 2 * XW, 1.f, nullptr, 0, 0, 0, (const float*)(ws + WS_RSM), nullptr, 0, 0};
              pg8::gemm_phase<pg8::EpiB<0>, pg8::StaticOrder, PG8_ALIGN, PG8_SP2>(F.lds + RING_OFF, g, S, E); }
            REPLOOP(17) s5_phase(F, A, l);
            REPLOOP(18) ret_phase(F);
            REPLOOP(19) diff_phase(F, A, l, l * 2 + rep);
            SEAM(pb + 1);
        }
        if (PHON(2) && IN(pb + 2)) { RELAUNDER();
            REPLOOP(2) {
            pg8::Gemm g{Gb, (const bf16*)(wl + WS_WGLU), T, 512, 512}; pg8::StaticOrder S; S.init(T, 512, F.G, launder_s((int)blockIdx.x));
            pg8::EpiB<3> E{MIXED + 512, DM, 1.f, Gb, 512, 0, 0, nullptr, nullptr, 0, 0};
            pg8::gemm_phase<pg8::EpiB<3>, pg8::StaticOrder, PG8_ALIGN, PG8_SP2>(F.lds + RING_OFF, g, S, E);
            }
            SEAM(pb + 2);
        }
        if (PHON(3) && IN(pb + 3)) { RELAUNDER();
            REPLOOP(3) {
            pg8::Gemm g{MIXED, (const bf16*)(wl + WS_WOUT), T, DM, DM}; pg8::StaticOrder S; S.init(T, DM, F.G, launder_s((int)blockIdx.x));
            pg8::EpiB<0> E{Yb, DM, 1.f, nullptr, 0, 0, 0, nullptr, nullptr, 0, 0};
            pg8::gemm_phase<pg8::EpiB<0>, pg8::StaticOrder, PG8_ALIGN, PG8_SP2>(F.lds + RING_OFF, g, S, E);
            }
            SEAM(pb + 3);
        }
        if (PHON(4) && IN(pb + 4)) { RELAUNDER();
            REPLOOP(4) {
            resnorm_phase(F, XB, Yb, A.in[I_GMIXPOST] + l * DM, REPLAST(4) ? XB : PROJ, RS, nullptr);
            }
            SEAM(pb + 4);
        }
        if (PHON(5) && IN(pb + 5)) { RELAUNDER();
            REPLOOP(5) {
            pg8::Gemm g{XB, (const bf16*)(wl + WS_WXQ), T, XW, DM}; pg8::StaticOrder S; S.init(T, XW, F.G, launder_s((int)blockIdx.x));
            pg8::EpiB<0> E{QX, XW, 0.12751743082459868f, nullptr, 0, 0, 2, RS, nullptr, 0, 0};
            pg8::gemm_phase<pg8::EpiB<0>, pg8::StaticOrder, PG8_ALIGN, PG8_SP2>(F.lds + RING_OFF, g, S, E);
            }
            SEAM(pb + 5);
        }
        if (PHON(6) && IN(pb + 6)) { RELAUNDER();
            REPLOOP(6) {
            xattn_phase(F, REPLAST(6) ? QX : Gb);
            }
            SEAM(pb + 6);
        }
        if (PHON(7) && IN(pb + 7)) { RELAUNDER();
            REPLOOP(7) {
            pg8::Gemm g{QX, (const bf16*)(wl + WS_WXO), T, DM, XW}; pg8::StaticOrder S; S.init(T, DM, F.G, launder_s((int)blockIdx.x));
            pg8::EpiB<0> E{Yb, DM, 1.f, nullptr, 0, 0, 0, nullptr, nullptr, 0, 0};
            pg8::gemm_phase<pg8::EpiB<0>, pg8::StaticOrder, PG8_ALIGN, PG8_SP2>(F.lds + RING_OFF, g, S, E);
            }
            SEAM(pb + 7);
        }
        if (PHON(8) && IN(pb + 8)) { RELAUNDER();
            REPLOOP(8) {
            resnorm_phase(F, XB, Yb, A.in[I_GXPOST] + l * DM, REPLAST(8) ? XB : PROJ, RS, nullptr);
            }
            SEAM(pb + 8);
        }
#pragma unroll 1
        for (int st = 0; st <= MLP_SPLIT; ++st) {
            if (IN(pb + 9 + st)) { RELAUNDER();
            bf16* const hid_dn = ((st - 1) & 1) ? MIXED : HID; bf16* const hid_up = (st & 1) ? MIXED : HID;
            if (PHON(10) && st > 0) { const int hf = st - 1;
            REPLOOP(10) {
                pg8::Gemm g{hid_dn, (const bf16*)(wl + WS_WDN), MLP_ROWS, DM, DFF}; pg8::StaticOrder S; S.init(MLP_ROWS, DM, F.G, launder_s((int)blockIdx.x));
                pg8::EpiB<0> E{Yb + (size_t)hf * MLP_ROWS * DM, DM, 1.f, nullptr, 0, 0, 0, nullptr, nullptr, 0, 0};
                pg8::gemm_phase<pg8::EpiB<0>, pg8::StaticOrder, PG8_ALIGN, PG8_SP2, true>(F.lds + RING_OFF, g, S, E);
            } }
            if (PHON(9) && st < MLP_SPLIT) { const int hf = st;
            REPLOOP(9) {
                pg8::Gemm g{XB + (size_t)hf * MLP_ROWS * DM, (const bf16*)(wl + WS_WUP), MLP_ROWS, DFF, DM}; pg8::StaticOrder S; S.init(MLP_ROWS, DFF, F.G, launder_s((int)blockIdx.x));
                pg8::EpiB<2> E{hid_up, DFF, 1.f, nullptr, 0, 0, 0, RS + (size_t)hf * MLP_ROWS, nullptr, 0, 1};
                pg8::gemm_phase<pg8::EpiB<2>, pg8::StaticOrder, PG8_ALIGN, PG8_SP2>(F.lds + RING_OFF, g, S, E);
            } }
            SEAM(pb + 9 + st);
            }
        }
        if (PHON(13) && IN(pb + 10 + MLP_SPLIT)) { RELAUNDER();
            REPLOOP(13) {
            if (l + 1 < DEPTH) resnorm_phase(F, XB, Yb, A.in[I_GMLPPOST] + l * DM, REPLAST(13) ? XB : PROJ, RS, nullptr);
            else resnorm_phase(F, XB, Yb, A.in[I_GMLPPOST] + l * DM, nullptr, nullptr, F.out);
            if (l + 1 < DEPTH) convert_weights(F, A, l + 1, F.vcu * NWAVES + F.wave, F.G * NWAVES, 0, 1);
            }
            SEAM(pb + 10 + MLP_SPLIT);
        }
    }
#undef IN
#undef SEAM
}

extern "C" void kernel_launch(void* const* d_in, const int* in_sizes, int n_in, void* d_out, int out_size, void* d_ws, size_t ws_size, hipStream_t stream) {
    static int grid = 0;
    if (grid == 0) {
        if (n_in != 32 || in_sizes[0] != T * DM || out_size != T * DM || ws_size < WS_END) { fprintf(stderr, "kernel_launch: shape mismatch (n_in %d, in0 %d, out %d, ws %zu, need %zu); nothing launched\n", n_in, n_in > 0 ? in_sizes[0] : -1, out_size, ws_size, (size_t)WS_END); grid = -1; return; }
        int dev = 0, cus = 0, per_cu = 0;
        if (hipGetDevice(&dev) != hipSuccess || hipDeviceGetAttribute(&cus, hipDeviceAttributeMultiprocessorCount, dev) != hipSuccess) { grid = -1; return; }
        if (hipFuncSetAttribute((const void*)hybrid_fwd, hipFuncAttributeMaxDynamicSharedMemorySize, LDS_BYTES) != hipSuccess) { fprintf(stderr, "kernel_launch: hipFuncSetAttribute failed\n"); grid = -1; return; }
        if (hipOccupancyMaxActiveBlocksPerMultiprocessor(&per_cu, (const void*)hybrid_fwd, NWAVES * 64, LDS_BYTES) != hipSuccess || per_cu < 1) { fprintf(stderr, "kernel_launch: occupancy query says %d blocks per CU\n", per_cu); }
        (void)hipGetLastError();
        grid = cus;
    }
    if (grid < 0) return;
    if (hipMemsetAsync((char*)d_ws + WS_CTL, 0, CTL_ZERO_BYTES, stream) != hipSuccess) return;
    Args a{};
    for (int i = 0; i < 32; ++i) a.in[i] = (const float*)d_in[i];
    a.out = (float*)d_out; a.ws = (unsigned char*)d_ws; a.pad = 0;
#if MK_ONE_LAUNCH
    a.ph_lo = 0; a.ph_hi = NPHASES; a.use_bar = 1;
    hipLaunchKernelGGL(hybrid_fwd, dim3(grid), dim3(NWAVES * 64), LDS_BYTES, stream, a);
#else
    for (int p = 0; p < NPHASES; ++p) { a.ph_lo = p; a.ph_hi = p + 1; a.use_bar = 0;
        hipLaunchKernelGGL(hybrid_fwd, dim3(grid), dim3(NWAVES * 64), LDS_BYTES, stream, a); }
#endif
    const hipError_t le = hipPeekAtLastError();
    if (le != hipSuccess) fprintf(stderr, "kernel_launch: launch failed: %s\n", hipGetErrorName(le));
}
```

```cpp
#include <hip/hip_runtime.h>
#include <cstdio>
#include <cstdint>
namespace pg8 {
#define PG8_LAS __attribute__((address_space(3)))
typedef unsigned short bf16_t;
typedef short bf16x8 __attribute__((ext_vector_type(8)));
typedef float f32x4 __attribute__((ext_vector_type(4)));
typedef unsigned u32x4 __attribute__((ext_vector_type(4)));
constexpr int BM = 256, BK = 64, HALF = 128, HTB = HALF * BK * 2  , STAGE_BYTES = 8 * HTB, NXCD = 8, WGM = 8;

__host__ __device__ __forceinline__ int lds_byte(int r, int c) { const int st = (r >> 4) * 2 + (c >> 5), rr = r & 15, cc = c & 31, ob = rr * 64 + cc * 2; return st * 1024 + (ob ^ (((ob >> 9) & 1) << 5)); }
__host__ __device__ __forceinline__ void stage_rc(int b, int& R, int& C) { const int st = b / 1024, sb = b % 1024, swz = sb ^ (((sb >> 9) & 1) << 5); R = (st >> 1) * 16 + swz / 64; C = (st & 1) * 32 + (swz % 64) / 2; }
__host__ __device__ __forceinline__ int perm32(int rho) { const int n = rho >> 4, i = rho & 15; return 8 * (i >> 2) + 4 * n + (i & 3); }

struct Unit { int pm, pn; };
struct Gemm { const bf16_t* A; const bf16_t* Bt; int M, N, K; };

struct StaticOrder {
    int nM, nN, nwg, G, c, wgm;
    __host__ __device__ void init(int M, int N, int G_, int c_, int wgm_ = WGM) { nM = M / BM; nN = N / BM; nwg = nM * nN; G = G_; c = c_; wgm = wgm_; }
    __host__ __device__ bool next(int i, Unit& u) const {
        const long L = (long)i * G + c; if (L >= nwg) return false;
        int wgid = (int)L; { const int q = nwg / NXCD, r = nwg % NXCD, xcd = wgid % NXCD, off = wgid / NXCD; wgid = (xcd < r ? xcd * (q + 1) : r * (q + 1) + (xcd - r) * q) + off; }
        const int nig = wgm * nN, gid = wgid / nig, fm = gid * wgm, gsz = (nM - fm) < wgm ? (nM - fm) : wgm;
        u.pm = fm + ((wgid % nig) % gsz); u.pn = (wgid % nig) / gsz; return true;
    }
    __device__ __forceinline__ void a_ready(const Unit&) const {}
    __device__ __forceinline__ void done(const Unit&) const {}
};

typedef float cvf32x2_t __attribute__((ext_vector_type(2))); typedef __bf16 cvbf16x2_t __attribute__((ext_vector_type(2)));
__device__ __forceinline__ unsigned cvt_pk_bf16(float lo, float hi) { const cvf32x2_t v = {lo, hi}; const cvbf16x2_t b = __builtin_convertvector(v, cvbf16x2_t); return __builtin_bit_cast(unsigned, b); }
__device__ __forceinline__ float bf_lo(unsigned w) { return __uint_as_float(w << 16); }
__device__ __forceinline__ float bf_hi(unsigned w) { return __uint_as_float(w & 0xffff0000u); }
template <int ACT> struct EpiB {
    static constexpr bool PERM = true, AFTER_DRAIN = false;
    bf16_t* O; int ldc; float scale; const bf16_t* Gp; int ldg; int sc_lo, sc_hi; const float* rs; bf16_t* sec; int sec_lo; int oblk;
    __device__ __forceinline__ void operator()(const f32x4 (&acc)[2][2][4][2], const Unit& u, int wr, int wc, int fr, int fq) const {
        const int row0 = u.pm * BM + wr * 64 + fr; const int col0 = u.pn * BM + wc * 32 + 8 * fq;
        float rsv8[2][4];
#pragma unroll
        for (int ai = 0; ai < 2; ++ai)
#pragma unroll
            for (int m = 0; m < 4; ++m) rsv8[ai][m] = rs ? rs[row0 + ai * HALF + m * 16] : 1.f;
#pragma unroll
        for (int ai = 0; ai < 2; ++ai) {
            u32x4 gwv[4][2];
            if (ACT == 3) {
#pragma unroll
                for (int m = 0; m < 4; ++m)
#pragma unroll
                    for (int bj = 0; bj < 2; ++bj) gwv[m][bj] = *(const u32x4*)(Gp + (size_t)(row0 + ai * HALF + m * 16) * ldg + col0 + bj * HALF); }
#pragma unroll
            for (int m = 0; m < 4; ++m) { const size_t row = (size_t)(row0 + ai * HALF + m * 16); bf16_t* rowp = O + row * ldc + col0; size_t bstep = HALF;
                if (oblk) { rowp = O + ((row >> 4) * (size_t)(ldc / 32) + (col0 >> 5)) * 512 + (row & 15) * 32 + (col0 & 31); bstep = 4 * 512; }
                if (ACT == 0 && sec && u.pn >= sec_lo) { const int t12 = u.pn - sec_lo;
                    rowp = sec + (size_t)(t12 >> 2) * ((size_t)32768 * 1024) + (((row >> 11) * 8 + 2 * (t12 & 3)) * 2048 + (row & 2047)) * 128 + wc * 32 + 8 * fq; bstep = (size_t)2048 * 128; } const float rsv = rsv8[ai][m];
#pragma unroll
                for (int bj = 0; bj < 2; ++bj) { f32x4 v0 = acc[ai][bj][m][0], v1 = acc[ai][bj][m][1];
                    if (ACT == 0) { const float sc = ((u.pn >= sc_lo && u.pn < sc_hi) ? scale : 1.f) * rsv; v0 = v0 * sc; v1 = v1 * sc; }
                    if (ACT == 2) {
#pragma unroll
                        for (int e = 0; e < 4; ++e) { const float a = fmaxf(v0[e] * rsv, 0.f), b = fmaxf(v1[e] * rsv, 0.f); v0[e] = a * a; v1[e] = b * b; } }
                    if (ACT == 3) { const u32x4 gw = gwv[m][bj];
                        const float g0 = bf_lo(gw.x), g1 = bf_hi(gw.x), g2 = bf_lo(gw.y), g3 = bf_hi(gw.y), g4 = bf_lo(gw.z), g5 = bf_hi(gw.z), g6 = bf_lo(gw.w), g7 = bf_hi(gw.w);
                        v0[0] = g0 / (1.f + __expf(-v0[0])); v0[1] = g1 / (1.f + __expf(-v0[1])); v0[2] = g2 / (1.f + __expf(-v0[2])); v0[3] = g3 / (1.f + __expf(-v0[3]));
                        v1[0] = g4 / (1.f + __expf(-v1[0])); v1[1] = g5 / (1.f + __expf(-v1[1])); v1[2] = g6 / (1.f + __expf(-v1[2])); v1[3] = g7 / (1.f + __expf(-v1[3])); }
                    u32x4 w; w.x = cvt_pk_bf16(v0[0], v0[1]); w.y = cvt_pk_bf16(v0[2], v0[3]); w.z = cvt_pk_bf16(v1[0], v1[1]); w.w = cvt_pk_bf16(v1[2], v1[3]);
                    *(u32x4*)(rowp + bj * bstep) = w; } } }
    }
};

template <class Epi, class Sched, bool ALIGN_EPI = false, bool SP2 = false, bool A_BLK = false>
__device__ __forceinline__ void gemm_phase(PG8_LAS unsigned char* lds, const Gemm g, const Sched& S, const Epi& E) {
    int tid_ = threadIdx.x; asm volatile("" : "+v"(tid_));
    const int tid = tid_, wid = __builtin_amdgcn_readfirstlane(tid >> 6), lane = tid & 63, wr = wid >> 2, wc = wid & 3, fr = lane & 15, fq = lane >> 4;
    const int K = g.K, nt = K / BK;
    unsigned voffA[2], voffB[2];
    static_assert(Epi::PERM, "the weight copies are stored in the row order of PERM epilogues");
#pragma unroll
    for (int i = 0; i < 2; ++i) { int R, C; stage_rc(tid * 16 + i * 8192, R, C);
        const unsigned blk = (unsigned)((((R >> 4) * (K / 32) + (C >> 5)) * 512 + (R & 15) * 32 + (C & 31)) * 2);
        voffA[i] = A_BLK ? blk : (unsigned)(R * K + C) * 2u; voffB[i] = blk; }
    const size_t kstepA = A_BLK ? (size_t)2048 : (size_t)(BK * 2), kstepB = 2048;
    const size_t hstep = (size_t)HALF * K * 2;
    const size_t tstep = 2 * hstep;
    const unsigned ldsw = (unsigned)wid * 1024u;
    const int aoff = lds_byte(wr * 64 + fr, fq * 8), boff = lds_byte(wc * 32 + fr, fq * 8);
#define PG8_SA(b, h) (((b) * 2 + (h)) * HTB)
#define PG8_SB(b, h) ((4 + (b) * 2 + (h)) * HTB)
#define PG8_STAGE(bufoff, gbase, voff) do { _Pragma("unroll") for (int _i = 0; _i < 2; ++_i) \
        __builtin_amdgcn_global_load_lds((const unsigned*)((const char*)(gbase) + (voff)[_i]), (PG8_LAS unsigned*)(lds + (bufoff) + ldsw + _i * 8192), 16, 0, 0); } while (0)
#define PG8_LDA(dst, b, h) do { _Pragma("unroll") for (int m = 0; m < 4; ++m) _Pragma("unroll") for (int k = 0; k < 2; ++k) dst[m][k] = *(const PG8_LAS bf16x8*)(lds + PG8_SA(b, h) + aoff + m * 2048 + k * 1024); } while (0)
#define PG8_LDB(dst, b, h) do { _Pragma("unroll") for (int n = 0; n < 2; ++n) _Pragma("unroll") for (int k = 0; k < 2; ++k) dst[n][k] = *(const PG8_LAS bf16x8*)(lds + PG8_SB(b, h) + boff + n * 2048 + k * 1024); } while (0)
#define PG8_MMA(ai, bj, At, Bt) do { __builtin_amdgcn_s_setprio(1); _Pragma("unroll") for (int m = 0; m < 4; ++m) _Pragma("unroll") for (int n = 0; n < 2; ++n) _Pragma("unroll") for (int k = 0; k < 2; ++k) \
        acc[ai][bj][m][n] = __builtin_amdgcn_mfma_f32_16x16x32_bf16(Bt[n][k], At[m][k], acc[ai][bj][m][n], 0, 0, 0); __builtin_amdgcn_s_setprio(0); } while (0)
#define PG8_WAIT_V(n) asm volatile("s_waitcnt vmcnt(" #n ")" ::: "memory")
#define PG8_WAIT_L(n) asm volatile("s_waitcnt lgkmcnt(" #n ")" ::: "memory")
#define PG8_BAR __builtin_amdgcn_s_barrier()
#define PG8_SCHED __builtin_amdgcn_sched_barrier(0)
    Unit cur, nxt; int ui = 0;
    if (!S.next(0, cur)) return;
    f32x4 acc[2][2][4][2];
#pragma unroll
    for (int a = 0; a < 2; ++a)
#pragma unroll
        for (int b = 0; b < 2; ++b)
#pragma unroll
            for (int m = 0; m < 4; ++m)
#pragma unroll
                for (int n = 0; n < 2; ++n) acc[a][b][m][n] = (f32x4){0.f, 0.f, 0.f, 0.f};
    bf16x8 At[4][2], B0[2][2], B1[2][2];
    const char* cA = (const char*)g.A + (size_t)cur.pm * tstep; const char* cB = (const char*)g.Bt + (size_t)cur.pn * tstep;
    S.a_ready(cur);
    if constexpr (SP2) {
        PG8_STAGE(PG8_SB(0, 0), cB, voffB); PG8_STAGE(PG8_SB(0, 1), cB + hstep, voffB); PG8_STAGE(PG8_SA(0, 0), cA, voffA); PG8_STAGE(PG8_SA(0, 1), cA + hstep, voffA);
        if (wr == 1) PG8_BAR;
        PG8_WAIT_V(2); PG8_BAR;
        PG8_STAGE(PG8_SB(1, 0), cB + kstepB, voffB); PG8_STAGE(PG8_SA(1, 0), cA + kstepA, voffA); PG8_STAGE(PG8_SB(1, 1), cB + hstep + kstepB, voffB);
        PG8_WAIT_V(6); PG8_BAR;
    } else {
        PG8_STAGE(PG8_SB(0, 0), cB, voffB); PG8_STAGE(PG8_SA(0, 0), cA, voffA); PG8_STAGE(PG8_SB(0, 1), cB + hstep, voffB); PG8_STAGE(PG8_SA(0, 1), cA + hstep, voffA);
        if (wr == 1) PG8_BAR;
        PG8_WAIT_V(4); PG8_BAR;
        PG8_STAGE(PG8_SB(1, 0), cB + kstepB, voffB); PG8_STAGE(PG8_SA(1, 0), cA + kstepA, voffA); PG8_STAGE(PG8_SB(1, 1), cB + hstep + kstepB, voffB);
        PG8_WAIT_V(6); PG8_BAR;
    }
    for (;;) {
        const bool has_next = S.next(ui + 1, nxt);
        const char* nA = has_next ? (const char*)g.A + (size_t)nxt.pm * tstep : cA; const char* nB = has_next ? (const char*)g.Bt + (size_t)nxt.pn * tstep : cB;
        for (int t = 0; t < nt; t += 2) {
            const bool last = (t == nt - 2);
            const char* a1 = cA + (size_t)(t + 1) * kstepA;
            const char* a2 = last ? nA : cA + (size_t)(t + 2) * kstepA; const char* b2 = last ? nB : cB + (size_t)(t + 2) * kstepB;
            const char* a3 = a2 + kstepA; const char* b3 = b2 + kstepB;
            if (last && has_next) S.a_ready(nxt);
            if constexpr (SP2) {
            PG8_LDB(B0, 0, 0); PG8_LDB(B1, 0, 1); PG8_SCHED; PG8_LDA(At, 0, 0); PG8_STAGE(PG8_SA(1, 1), a1 + hstep, voffA);
            PG8_WAIT_V(8); PG8_WAIT_L(0); PG8_BAR; PG8_MMA(0, 0, At, B0); PG8_MMA(0, 1, At, B1); PG8_BAR; PG8_SCHED;
            PG8_LDA(At, 0, 1); PG8_STAGE(PG8_SB(0, 0), b2, voffB); PG8_STAGE(PG8_SB(0, 1), b2 + hstep, voffB); PG8_STAGE(PG8_SA(0, 0), a2, voffA);
            PG8_WAIT_V(8); PG8_WAIT_L(0); PG8_BAR; PG8_MMA(1, 0, At, B0); PG8_MMA(1, 1, At, B1); PG8_BAR; PG8_SCHED;
            PG8_LDB(B0, 1, 0); PG8_LDB(B1, 1, 1); PG8_SCHED; PG8_LDA(At, 1, 0); PG8_STAGE(PG8_SA(0, 1), a2 + hstep, voffA);
            PG8_WAIT_V(8); PG8_WAIT_L(0); PG8_BAR; PG8_MMA(0, 0, At, B0); PG8_MMA(0, 1, At, B1); PG8_BAR; PG8_SCHED;
            PG8_LDA(At, 1, 1); PG8_STAGE(PG8_SB(1, 0), b3, voffB); PG8_STAGE(PG8_SB(1, 1), b3 + hstep, voffB); PG8_STAGE(PG8_SA(1, 0), a3, voffA);
            PG8_WAIT_V(8); PG8_WAIT_L(0); PG8_BAR; PG8_MMA(1, 0, At, B0); PG8_MMA(1, 1, At, B1); PG8_BAR; PG8_SCHED;
            } else {
            PG8_LDB(B0, 0, 0); PG8_SCHED; PG8_LDA(At, 0, 0); PG8_STAGE(PG8_SA(1, 1), a1 + hstep, voffA);
            PG8_WAIT_L(8); PG8_BAR; PG8_WAIT_L(0); PG8_MMA(0, 0, At, B0); PG8_BAR; PG8_SCHED;
            PG8_LDB(B1, 0, 1); PG8_STAGE(PG8_SB(0, 0), b2, voffB);
            PG8_BAR; PG8_WAIT_L(0); PG8_MMA(0, 1, At, B1); PG8_BAR;
            PG8_LDA(At, 0, 1); PG8_STAGE(PG8_SA(0, 0), a2, voffA);
            PG8_BAR; PG8_WAIT_L(0); PG8_MMA(1, 0, At, B0); PG8_BAR; PG8_SCHED;
            PG8_STAGE(PG8_SB(0, 1), b2 + hstep, voffB);
            PG8_WAIT_V(6); PG8_BAR; PG8_MMA(1, 1, At, B1); PG8_BAR;
            PG8_LDB(B0, 1, 0); PG8_SCHED; PG8_LDA(At, 1, 0); PG8_STAGE(PG8_SA(0, 1), a2 + hstep, voffA);
            PG8_WAIT_L(8); PG8_BAR; PG8_WAIT_L(0); PG8_MMA(0, 0, At, B0); PG8_BAR; PG8_SCHED;
            PG8_LDB(B1, 1, 1); PG8_STAGE(PG8_SB(1, 0), b3, voffB);
            PG8_BAR; PG8_WAIT_L(0); PG8_MMA(0, 1, At, B1); PG8_BAR;
            PG8_LDA(At, 1, 1); PG8_STAGE(PG8_SA(1, 0), a3, voffA);
            PG8_BAR; PG8_WAIT_L(0); PG8_MMA(1, 0, At, B0); PG8_BAR; PG8_SCHED;
            PG8_STAGE(PG8_SB(1, 1), b3 + hstep, voffB);
            PG8_WAIT_V(6); PG8_BAR; PG8_MMA(1, 1, At, B1); PG8_BAR;
            }
        }
        if constexpr (ALIGN_EPI) { if (wr == 0) PG8_BAR; }
        if constexpr (!Epi::AFTER_DRAIN) { E(acc, cur, wr, wc, fr, fq); S.done(cur); }
        if (!has_next) break;
#pragma unroll
        for (int a = 0; a < 2; ++a)
#pragma unroll
            for (int b = 0; b < 2; ++b)
#pragma unroll
                for (int m = 0; m < 4; ++m)
#pragma unroll
                    for (int n = 0; n < 2; ++n) acc[a][b][m][n] = (f32x4){0.f, 0.f, 0.f, 0.f};
        cur = nxt; cA = nA; cB = nB; ++ui;
        if constexpr (ALIGN_EPI) { if (wr == 1) PG8_BAR; }
    }
    PG8_WAIT_V(0);
    if constexpr (!ALIGN_EPI) { if (wr == 0) PG8_BAR; }
    PG8_BAR;
    if constexpr (Epi::AFTER_DRAIN) { E.fused(acc, cur, wr, wc, fr, fq, lds, wid, lane); S.done(cur); }
#undef PG8_SA
#undef PG8_SB
#undef PG8_STAGE
#undef PG8_LDA
#undef PG8_LDB
#undef PG8_MMA
#undef PG8_WAIT_V
#undef PG8_WAIT_L
#undef PG8_BAR
#undef PG8_SCHED
}

}
namespace at16 {
typedef float f32x4 __attribute__((ext_vector_type(4)));
typedef short bf16x8 __attribute__((ext_vector_type(8)));
typedef short s16x4 __attribute__((ext_vector_type(4)));
typedef unsigned u32x4 __attribute__((ext_vector_type(4)));
typedef int i32x4 __attribute__((ext_vector_type(4)));
constexpr int KT_BYTES = 64 * 256, VT_BYTES = 64 * 256;
constexpr int NBUF = 4, OFF_V = NBUF * KT_BYTES, OFF_LUT = OFF_V + NBUF * VT_BYTES, OFF_KPOS = OFF_LUT + 544, OFF_KMAX = OFF_KPOS + 2048 * 4, LDS_NEED = OFF_KMAX + 32 * 4;
constexpr float THR = 8.f;
typedef float cvf32x2_t __attribute__((ext_vector_type(2))); typedef __bf16 cvbf16x2_t __attribute__((ext_vector_type(2)));
__device__ __forceinline__ unsigned cvtpk(float lo, float hi) { const cvf32x2_t v = {lo, hi}; const cvbf16x2_t b = __builtin_convertvector(v, cvbf16x2_t); return __builtin_bit_cast(unsigned, b); }
typedef short v4i16_t __attribute__((ext_vector_type(4)));
__device__ __forceinline__ s16x4 vtr(const __attribute__((address_space(3))) unsigned char* p) { return __builtin_bit_cast(s16x4, __builtin_amdgcn_ds_read_tr16_b64_v4i16((__attribute__((address_space(3))) v4i16_t*)p)); }

struct Unit {
    const unsigned short* Q; int ldq;
    const unsigned short* K; int ldk;
    const unsigned short* V; int ldv;
    int NT;
    const int* posq; const int* posk;
    const float* lut; int lut_stride;
    int q0;
};

template <int NMAP, int KS, bool DIFF>
__device__ __forceinline__ void run(const Unit& U, __attribute__((address_space(3))) unsigned char* lds, f32x4 (&o)[NMAP][8], float (&inv)[NMAP][4], const bool resident = false) {
    typedef __attribute__((address_space(3))) unsigned char* lptr;
    int tid_ = threadIdx.x; asm volatile("" : "+v"(tid_));
    const int tid = tid_, lane = tid & 63, wid = __builtin_amdgcn_readfirstlane(tid >> 6), i = lane & 15, g = lane >> 4;
    const unsigned ldsb = (unsigned)(uintptr_t)lds;
    unsigned kvo[2], vvo[2];
#pragma unroll
    for (int j = 0; j < 2; ++j) { const int row = 4 * (wid + 8 * j) + (lane >> 4), p = lane & 15;
        kvo[j] = (unsigned)(row * U.ldk + ((p ^ (row & 15)) * 8)) * 2u; vvo[j] = (unsigned)(row * U.ldv + ((p ^ (2 * (row & 7))) * 8)) * 2u; }
#define AT_DMA(gbase, voff, ldst) do { unsigned keep_; asm volatile("s_mov_b32 %0, m0\n\ts_mov_b32 m0, %3\n\ts_nop 0\n\tglobal_load_lds_dwordx4 %1, %2\n\ts_mov_b32 m0, %0" : "=&s"(keep_) : "v"(voff), "s"(gbase), "s"(ldst) : "memory"); } while (0)
#define AT_LOAD(t, bi) do { const unsigned short* kt_ = U.K + (size_t)(t) * 64 * U.ldk; const unsigned short* vt_ = U.V + (size_t)(t) * 64 * U.ldv; \
        _Pragma("unroll") for (int j_ = 0; j_ < 2; ++j_) { \
            AT_DMA(kt_, kvo[j_], (unsigned)__builtin_amdgcn_readfirstlane(ldsb + (bi) * KT_BYTES + (wid + 8 * j_) * 1024)); \
            AT_DMA(vt_, vvo[j_], (unsigned)__builtin_amdgcn_readfirstlane(ldsb + OFF_V + (bi) * VT_BYTES + (wid + 8 * j_) * 1024)); } } while (0)
    if (!resident) { AT_LOAD(0, 0); if (U.NT > 1) AT_LOAD(1, 1); }
    bf16x8 qf[NMAP][KS];
    { const unsigned short* qp = U.Q + (size_t)(wid * 16 + i) * U.ldq + 8 * g;
#pragma unroll
      for (int m = 0; m < NMAP; ++m)
#pragma unroll
        for (int ks = 0; ks < KS; ++ks) qf[m][ks] = *(const bf16x8*)(qp + (m * KS + ks) * 32); }
    int posq = 0, minposq = 0; float bias_far = 0.f;
    if (DIFF) {
        const int nk4 = U.NT * 16;
        float lutv = U.lut[(tid < 128 ? tid : 128) * U.lut_stride];
        i32x4 kposv = ((const i32x4*)U.posk)[tid < nk4 ? tid : nk4 - 1];
        posq = U.posq[wid * 16 + i]; bias_far = U.lut[128 * U.lut_stride];
        asm volatile("" : "+v"(lutv), "+v"(kposv), "+v"(posq), "+v"(bias_far));
        if (tid < 129) ((__attribute__((address_space(3))) float*)(lds + OFF_LUT))[tid] = lutv;
        if (tid < nk4) ((__attribute__((address_space(3))) i32x4*)(lds + OFF_KPOS))[tid] = kposv;
        minposq = posq;
#pragma unroll
        for (int k_ = 0; k_ < 4; ++k_) { const int ctrl_ = (k_ == 0) ? 0xB1 : (k_ == 1) ? 0x4E : (k_ == 2) ? 0x124 : 0x128;
            const int t_ = (k_ == 0) ? __builtin_amdgcn_update_dpp(0, minposq, 0xB1, 0xF, 0xF, true) : (k_ == 1) ? __builtin_amdgcn_update_dpp(0, minposq, 0x4E, 0xF, 0xF, true)
                         : (k_ == 2) ? __builtin_amdgcn_update_dpp(0, minposq, 0x124, 0xF, 0xF, true) : __builtin_amdgcn_update_dpp(0, minposq, 0x128, 0xF, 0xF, true);
            (void)ctrl_; minposq = t_ < minposq ? t_ : minposq; }
        minposq = __builtin_amdgcn_readfirstlane(minposq);
    }
#pragma unroll
    for (int m = 0; m < NMAP; ++m)
#pragma unroll
        for (int d = 0; d < 8; ++d) o[m][d] = (f32x4){0.f, 0.f, 0.f, 0.f};
    float mrun[NMAP], lrun[NMAP];
#pragma unroll
    for (int m = 0; m < NMAP; ++m) { mrun[m] = 0.f; lrun[m] = 0.f; }
    asm volatile("s_waitcnt vmcnt(0)" ::: "memory");
    __syncthreads();
    if (DIFF) {
#pragma unroll
        for (int k = 0; k < 4; ++k) { const int tt = 4 * wid + k; if (tt < U.NT) { int mx_ = ((__attribute__((address_space(3))) int*)(lds + OFF_KPOS))[tt * 64 + lane];
#pragma unroll
            for (int k_ = 0; k_ < 4; ++k_) {
                const int t_ = (k_ == 0) ? __builtin_amdgcn_update_dpp(0, mx_, 0xB1, 0xF, 0xF, true) : (k_ == 1) ? __builtin_amdgcn_update_dpp(0, mx_, 0x4E, 0xF, 0xF, true)
                             : (k_ == 2) ? __builtin_amdgcn_update_dpp(0, mx_, 0x124, 0xF, 0xF, true) : __builtin_amdgcn_update_dpp(0, mx_, 0x128, 0xF, 0xF, true);
                mx_ = t_ > mx_ ? t_ : mx_; }
            { auto r16 = __builtin_amdgcn_permlane16_swap((unsigned)mx_, (unsigned)mx_, false, false); const int a_ = (int)r16[0], b_ = (int)r16[1]; mx_ = a_ > b_ ? a_ : b_; }
            { auto r32 = __builtin_amdgcn_permlane32_swap((unsigned)mx_, (unsigned)mx_, false, false); const int a_ = (int)r32[0], b_ = (int)r32[1]; mx_ = a_ > b_ ? a_ : b_; }
            if (lane == 0) ((__attribute__((address_space(3))) int*)(lds + OFF_KMAX))[tt] = mx_; } }
        __syncthreads();
    }
    asm volatile("" : "+v"(bias_far), "+v"(posq));
#pragma unroll
    for (int m = 0; m < NMAP; ++m)
#pragma unroll
        for (int ks = 0; ks < KS; ++ks) asm volatile("" : "+v"(qf[m][ks]));
    const lptr kbase = lds + i * 256;
    const unsigned vlane = 256 * (4 * g + ((lane >> 2) & 3)) + 32 * (4 * (g & 1) + ((lane >> 2) & 3)) + 16 * ((lane & 3) >> 1) + 8 * (lane & 1);
    const int qidx = U.q0 + wid * 16 + i;
    const int grp = wid >> 2;
    bf16x8 pa[NMAP][2];
    f32x4 sh[NMAP][2];
#define AT_TILEWAIT(tt) do { if (resident) {} else if ((tt) + 2 < U.NT) asm volatile("s_waitcnt vmcnt(4)" ::: "memory"); else asm volatile("s_waitcnt vmcnt(0)" ::: "memory"); } while (0)
    if (!resident && grp == 1 && 2 < U.NT) AT_LOAD(2, 2);
#pragma unroll 1
    for (int t = 0; t < U.NT; ++t) {
        const int b = t & 3;
        const bool active = !DIFF || (t * 64 <= U.q0 + wid * 16 + 15);
        if (!resident && grp == 0 && t + 2 < U.NT) AT_LOAD(t + 2, (t + 2) & 3);
        if (active) {
            const lptr kb = kbase + b * KT_BYTES;
            f32x4 s[NMAP][4];
            bf16x8 kf[2][4];
#define AT_KLD(st_) do { _Pragma("unroll") for (int blk = 0; blk < 4; ++blk) kf[(st_) & 1][blk] = *(const __attribute__((address_space(3))) bf16x8*)(kb + blk * 4096 + 16 * (((((st_) / KS) * KS * 4) + 4 * ((st_) % KS) + g) ^ i)); } while (0)
            AT_KLD(0);
            {
                bool far = true;
                if (DIFF) {
                    const int kmax = ((__attribute__((address_space(3))) int*)(lds + OFF_KMAX))[t];
                    const bool diag = (t * 64 + 63 > U.q0 + wid * 16);
                    far = (minposq - kmax >= 128) && !diag;
                }
                if (far) {
#pragma unroll
                    for (int m = 0; m < NMAP; ++m) { const float c = (DIFF ? bias_far : 0.f) - mrun[m];
#pragma unroll
                        for (int blk = 0; blk < 4; ++blk) s[m][blk] = (f32x4){c, c, c, c}; }
                } else {
#pragma unroll
                    for (int blk = 0; blk < 4; ++blk) { const i32x4 pk = *(const __attribute__((address_space(3))) i32x4*)(lds + OFF_KPOS + (t * 64 + 16 * blk + 4 * g) * 4);
                        f32x4 bia;
#pragma unroll
                        for (int r = 0; r < 4; ++r) { int n = posq - pk[r]; n = n < 0 ? 0 : (n > 128 ? 128 : n);
                            float bv = ((__attribute__((address_space(3))) float*)(lds + OFF_LUT))[n];
                            if (t * 64 + 16 * blk + 4 * g + r > qidx) bv = -INFINITY;
                            bia[r] = bv; }
#pragma unroll
                        for (int m = 0; m < NMAP; ++m) s[m][blk] = bia - mrun[m]; }
                }
            }
            {
#pragma unroll
                for (int st = 0; st < NMAP * KS; ++st) { const int m = st / KS, ks = st % KS;
                    if (st + 1 < NMAP * KS) AT_KLD(st + 1);
#pragma unroll
                    for (int blk = 0; blk < 4; ++blk) s[m][blk] = __builtin_amdgcn_mfma_f32_16x16x32_bf16(kf[st & 1][blk], qf[m][ks], s[m][blk], 0, 0, 0);
                }
            }
#undef AT_KLD
            float mx[NMAP]; bool grow = (t == 0);
#pragma unroll
            for (int m = 0; m < NMAP; ++m) {
                float a = fmaxf(fmaxf(s[m][0][0], s[m][0][1]), s[m][0][2]), b2 = fmaxf(fmaxf(s[m][0][3], s[m][1][0]), s[m][1][1]);
                a = fmaxf(fmaxf(a, s[m][1][2]), s[m][1][3]); b2 = fmaxf(fmaxf(b2, s[m][2][0]), s[m][2][1]); a = fmaxf(fmaxf(a, s[m][2][2]), s[m][2][3]);
                b2 = fmaxf(fmaxf(b2, s[m][3][0]), s[m][3][1]); a = fmaxf(fmaxf(a, s[m][3][2]), s[m][3][3]); a = fmaxf(a, b2);
                mx[m] = a; grow = grow || (a > THR);
            }
            if (__any(grow)) {
#pragma unroll
                for (int m = 0; m < NMAP; ++m) {
                    { float a = mx[m];
                      { auto r16 = __builtin_amdgcn_permlane16_swap(__float_as_uint(a), __float_as_uint(a), false, false); a = fmaxf(__uint_as_float(r16[0]), __uint_as_float(r16[1])); }
                      { auto r32 = __builtin_amdgcn_permlane32_swap(__float_as_uint(a), __float_as_uint(a), false, false); a = fmaxf(__uint_as_float(r32[0]), __uint_as_float(r32[1])); }
                      mx[m] = a; }
                    const float dl = (t == 0) ? mx[m] : fmaxf(mx[m], 0.f), al = __builtin_amdgcn_exp2f(-dl); mrun[m] += dl; lrun[m] *= al;
#pragma unroll
                    for (int blk = 0; blk < 4; ++blk) s[m][blk] = s[m][blk] - dl;
                    if (t > 0) {
#pragma unroll
                        for (int r = 0; r < 4; ++r) { const float ar = __shfl(al, 4 * g + r);
#pragma unroll
                            for (int d = 0; d < 8; ++d) o[m][d][r] *= ar; } }
                }
            }
#pragma unroll
            for (int m = 0; m < NMAP; ++m) {
#pragma unroll
                for (int blk = 0; blk < 2; ++blk)
#pragma unroll
                    for (int r = 0; r < 4; ++r) s[m][blk][r] = __builtin_amdgcn_exp2f(s[m][blk][r]);
                lrun[m] += (s[m][0][0] + s[m][0][1]) + (s[m][0][2] + s[m][0][3]) + (s[m][1][0] + s[m][1][1]) + (s[m][1][2] + s[m][1][3]);
                { u32x4 w; w.x = cvtpk(s[m][0][0], s[m][0][1]); w.y = cvtpk(s[m][0][2], s[m][0][3]); w.z = cvtpk(s[m][1][0], s[m][1][1]); w.w = cvtpk(s[m][1][2], s[m][1][3]); pa[m][0] = __builtin_bit_cast(bf16x8, w); }
                sh[m][0] = s[m][2]; sh[m][1] = s[m][3];
            }
        }
        if (grp == 1) { AT_TILEWAIT(t); __syncthreads(); }
        if (!resident && grp == 1 && t + 3 < U.NT) AT_LOAD(t + 3, (t + 3) & 3);
        if (active) {
            s16x4 vlo[2], vhi[2];
            __builtin_amdgcn_s_setprio(1);
#define AT_VLD1(d, s2) do { const lptr vb_ = lds + OFF_V + b * VT_BYTES + (vlane ^ (32u * (d))); vlo[(d) & 1] = vtr(vb_ + (32 * (s2)) * 256); vhi[(d) & 1] = vtr(vb_ + (32 * (s2) + 16) * 256); } while (0)
            AT_VLD1(0, 0);
#pragma unroll
            for (int d = 0; d < 8; ++d) { if (d + 1 < 8) AT_VLD1(d + 1, 0);
                const bf16x8 vf_ = (bf16x8){vlo[d & 1][0], vlo[d & 1][1], vlo[d & 1][2], vlo[d & 1][3], vhi[d & 1][0], vhi[d & 1][1], vhi[d & 1][2], vhi[d & 1][3]};
#pragma unroll
                for (int m = 0; m < NMAP; ++m) o[m][d] = __builtin_amdgcn_mfma_f32_16x16x32_bf16(pa[m][0], vf_, o[m][d], 0, 0, 0);
#pragma unroll
                for (int m = 0; m < NMAP; ++m) { const int blk = d >> 2, r = d & 3; sh[m][blk][r] = __builtin_amdgcn_exp2f(sh[m][blk][r]); }
            }
#pragma unroll
            for (int m = 0; m < NMAP; ++m) {
                lrun[m] += (sh[m][0][0] + sh[m][0][1]) + (sh[m][0][2] + sh[m][0][3]) + (sh[m][1][0] + sh[m][1][1]) + (sh[m][1][2] + sh[m][1][3]);
                u32x4 w; w.x = cvtpk(sh[m][0][0], sh[m][0][1]); w.y = cvtpk(sh[m][0][2], sh[m][0][3]); w.z = cvtpk(sh[m][1][0], sh[m][1][1]); w.w = cvtpk(sh[m][1][2], sh[m][1][3]); pa[m][1] = __builtin_bit_cast(bf16x8, w);
            }
            AT_VLD1(0, 1);
#pragma unroll
            for (int d = 0; d < 8; ++d) { if (d + 1 < 8) AT_VLD1(d + 1, 1);
                const bf16x8 vf_ = (bf16x8){vlo[d & 1][0], vlo[d & 1][1], vlo[d & 1][2], vlo[d & 1][3], vhi[d & 1][0], vhi[d & 1][1], vhi[d & 1][2], vhi[d & 1][3]};
#pragma unroll
                for (int m = 0; m < NMAP; ++m) o[m][d] = __builtin_amdgcn_mfma_f32_16x16x32_bf16(pa[m][1], vf_, o[m][d], 0, 0, 0);
            }
            __builtin_amdgcn_s_setprio(0);
#undef AT_VLD1
        }
        if (grp == 0) { AT_TILEWAIT(t); __syncthreads(); }
    }
    __syncthreads();
#undef AT_TILEWAIT
#undef AT_LOAD
#undef AT_DMA
#pragma unroll
    for (int m = 0; m < NMAP; ++m) { float lt = lrun[m]; lt += __shfl_xor(lt, 16); lt += __shfl_xor(lt, 32);
#pragma unroll
        for (int r = 0; r < 4; ++r) inv[m][r] = 1.0f / __shfl(lt, 4 * g + r); }
}
}
namespace s5f {
typedef float f32x4 __attribute__((ext_vector_type(4)));
typedef short bf16x8 __attribute__((ext_vector_type(8)));
typedef unsigned u32x4 __attribute__((ext_vector_type(4)));
typedef unsigned u32x2 __attribute__((ext_vector_type(2)));
#define S5_LAS __attribute__((address_space(3)))
constexpr int UB_STR = 1056, XB_STR = 288;
constexpr int OFF_UB = 0, OFF_XB = 64 * UB_STR, OFF_SC = OFF_XB + 64 * XB_STR, OFF_KT = OFF_SC + 64 * 128 * 4, LDS_NEED = OFF_KT + 16384;
constexpr size_t C_KT = 0, C_QM = 1u << 20, C_PM = 5u << 20, C_AL = 9u << 20;

__device__ __forceinline__ void sincos_dd(double ang, double& s, double& c) {
    const double q = __builtin_rint(ang * 0.63661977236758134308);
    double r = __builtin_fma(-q, 1.57079632679489655800, ang); r = __builtin_fma(-q, 6.12323399573676603587e-17, r);
    const int qi = ((int)q) & 3; const double r2 = r * r;
    const double sr = r * (1.0 + r2 * (-1.0 / 6 + r2 * (1.0 / 120 + r2 * (-1.0 / 5040 + r2 * (1.0 / 362880 + r2 * (-1.0 / 39916800 + r2 * (1.0 / 6227020800.0 + r2 * (-1.0 / 1307674368000.0))))))));
    const double cr = 1.0 + r2 * (-0.5 + r2 * (1.0 / 24 + r2 * (-1.0 / 720 + r2 * (1.0 / 40320 + r2 * (-1.0 / 3628800 + r2 * (1.0 / 479001600.0 + r2 * (-1.0 / 87178291200.0 + r2 * (1.0 / 20922789888000.0))))))));
    s = (qi == 0) ? sr : (qi == 1) ? cr : (qi == 2) ? -sr : -cr;
    c = (qi == 0) ? cr : (qi == 1) ? -sr : (qi == 2) ? -cr : sr;
}
struct Basics { double lrdt, th; float fre, fim; };
__device__ __forceinline__ Basics basics(const float* lam_re, const float* lam_im, const float* log_dt, int l, int g, int p) {
    Basics B; const double lr = (double)fminf(lam_re[(l * 32 + g) * 64 + p], -1e-4f), li = (double)lam_im[(l * 32 + g) * 64 + p], dt = exp((double)log_dt[l * 32 + g]);
    B.lrdt = lr * dt; B.th = li * dt;
    double sn, cs; sincos_dd(B.th, sn, cs); const double mag = exp(B.lrdt), nr = mag * cs - 1.0, ni = mag * sn, den = lr * lr + li * li;
    B.fre = (float)((nr * lr + ni * li) / den); B.fim = (float)((ni * lr - nr * li) / den);
    return B;
}
__device__ __forceinline__ void apow(const Basics& B, int n, float& re, float& im) {
    double sn, cs; sincos_dd(B.th * (double)n, sn, cs); const double mag = exp(B.lrdt * (double)n); re = (float)(mag * cs); im = (float)(mag * sn);
}
#define S5_DPP(v, ctrl) __builtin_bit_cast(float, __builtin_amdgcn_update_dpp(0, __builtin_bit_cast(int, (v)), (ctrl), 0xF, 0xF, true))
__device__ __forceinline__ float wsum(float v) {
    v += S5_DPP(v, 0xB1); v += S5_DPP(v, 0x4E); v += S5_DPP(v, 0x124); v += S5_DPP(v, 0x128);
    v += __shfl_xor(v, 16); v += __shfl_xor(v, 32);
    return v;
}
__device__ __forceinline__ unsigned short f2bf_(float f) { unsigned u = __builtin_bit_cast(unsigned, f); return (unsigned short)((u + 0x7fffu + ((u >> 16) & 1u)) >> 16); }

__device__ __forceinline__ void consts(unsigned char* cbase, const float* lam_re, const float* lam_im, const float* log_dt, const float* b_re, const float* b_im, const float* c_re, const float* c_im,
                                       int l, int gw, int NGW, int lane) {
    unsigned short* KT = (unsigned short*)(cbase + C_KT); unsigned short* QM = (unsigned short*)(cbase + C_QM); unsigned short* PM = (unsigned short*)(cbase + C_PM); float* AL = (float*)(cbase + C_AL);
    for (int task = gw; task < 32 * 32; task += NGW) {
        const int g = task >> 5, tau = task & 31, p = lane;
        const Basics B = basics(lam_re, lam_im, log_dt, l, g, p);
        float ar, ai; apow(B, tau, ar, ai);
        float bbr[16], bbi[16];
#pragma unroll
        for (int j = 0; j < 16; ++j) { const float br = b_re[((size_t)(l * 32 + g) * 64 + p) * 16 + j], bi = b_im[((size_t)(l * 32 + g) * 64 + p) * 16 + j]; bbr[j] = B.fre * br - B.fim * bi; bbi[j] = B.fre * bi + B.fim * br; }
        float crv[16], civ[16];
#pragma unroll
        for (int h = 0; h < 16; ++h) { crv[h] = c_re[((size_t)(l * 32 + g) * 16 + h) * 64 + p]; civ[h] = c_im[((size_t)(l * 32 + g) * 16 + h) * 64 + p]; }
#pragma unroll
        for (int h = 0; h < 16; ++h) {
            const float cr = crv[h], ci = civ[h];
            const float car = cr * ar - ci * ai, cai = cr * ai + ci * ar;
            float sel = 0.f;
#pragma unroll
            for (int j = 0; j < 16; ++j) { float v = car * bbr[j] - cai * bbi[j];
                v = wsum(v);
                sel = (lane == j) ? v : sel; }
            if (lane < 16) KT[((size_t)(g * 32 + tau) * 16 + h) * 16 + lane] = f2bf_(sel);
        }
    }
    for (int task = gw * 64 + lane; task < 32 * 32 * 64; task += NGW * 64) {
        const int p = task & 63, n = (task >> 6) & 31, g = task >> 11;
        const Basics B = basics(lam_re, lam_im, log_dt, l, g, p);
        float crv[16], civ[16], brv[16], biv[16];
#pragma unroll
        for (int h = 0; h < 16; ++h) { crv[h] = c_re[((size_t)(l * 32 + g) * 16 + h) * 64 + p]; civ[h] = c_im[((size_t)(l * 32 + g) * 16 + h) * 64 + p]; }
#pragma unroll
        for (int j = 0; j < 16; ++j) { brv[j] = b_re[((size_t)(l * 32 + g) * 64 + p) * 16 + j]; biv[j] = b_im[((size_t)(l * 32 + g) * 64 + p) * 16 + j]; }
        float ar, ai; apow(B, n + 1, ar, ai);
#pragma unroll
        for (int h = 0; h < 16; ++h) { const float cr = crv[h], ci = civ[h];
            QM[((size_t)g * 512 + n * 16 + h) * 128 + p] = f2bf_(cr * ar - ci * ai); QM[((size_t)g * 512 + n * 16 + h) * 128 + 64 + p] = f2bf_(-(cr * ai + ci * ar)); }
        apow(B, 31 - n, ar, ai);
#pragma unroll
        for (int j = 0; j < 16; ++j) { const float br = brv[j], bi = biv[j];
            const float bbr = B.fre * br - B.fim * bi, bbi = B.fre * bi + B.fim * br;
            PM[((size_t)g * 128 + p) * 512 + n * 16 + j] = f2bf_(ar * bbr - ai * bbi); PM[((size_t)g * 128 + 64 + p) * 512 + n * 16 + j] = f2bf_(ar * bbi + ai * bbr); }
        if (n == 0) { apow(B, 32, ar, ai); AL[(g * 64 + p) * 2] = ar; AL[(g * 64 + p) * 2 + 1] = ai; }
    }
}

__device__ __forceinline__ float gelu_tanh(float x) { const float u = 0.7978845608028654f * (x + 0.044715f * x * x * x); const float e = __expf(2.f * u); return 0.5f * x * (2.f - 2.f / (e + 1.f)); }

__device__ __forceinline__ void unit(const unsigned short* proj_su, int ldp, unsigned short* Gout, const unsigned char* cbase, int g, const float* dsk, S5_LAS unsigned char* lds) {
    int tid_ = threadIdx.x; asm volatile("" : "+v"(tid_));
    const int tid = tid_, lane = tid & 63, w = __builtin_amdgcn_readfirstlane(tid >> 6), i = lane & 15, gq = lane >> 4;
    const unsigned short* KTg = (const unsigned short*)(cbase + C_KT) + (size_t)g * 32 * 256;
    const unsigned short* QMg = (const unsigned short*)(cbase + C_QM) + (size_t)g * 512 * 128;
    const unsigned short* PMg = (const unsigned short*)(cbase + C_PM) + (size_t)g * 128 * 512;
    const float* ALg = (const float*)(cbase + C_AL) + g * 128;
    bf16x8 pa[16];
#pragma unroll
    for (int ks = 0; ks < 16; ++ks) pa[ks] = *(const bf16x8*)(PMg + (size_t)(16 * w + i) * 512 + 32 * ks + 8 * gq);
    {
        u32x4 uv[4][2], kv2[2];
#pragma unroll
        for (int k = 0; k < 4; ++k) { const int idx = tid + 512 * k, c = idx >> 5, s = idx & 31; const unsigned short* src = proj_su + (size_t)(c * 32 + s) * ldp; uv[k][0] = *(const u32x4*)src; uv[k][1] = *(const u32x4*)(src + 8); }
#pragma unroll
        for (int k = 0; k < 2; ++k) { const int idx = tid + 512 * k; kv2[k] = *(const u32x4*)(KTg + idx * 8); }
#pragma unroll
        for (int k = 0; k < 4; ++k) { asm volatile("" : "+v"(uv[k][0]), "+v"(uv[k][1])); }
#pragma unroll
        for (int k = 0; k < 2; ++k) { asm volatile("" : "+v"(kv2[k])); }
#pragma unroll
        for (int k = 0; k < 4; ++k) { const int idx = tid + 512 * k, c = idx >> 5, s = idx & 31;
            *(S5_LAS u32x4*)(lds + OFF_UB + c * UB_STR + s * 32) = uv[k][0]; *(S5_LAS u32x4*)(lds + OFF_UB + c * UB_STR + s * 32 + 16) = uv[k][1]; }
#pragma unroll
        for (int k = 0; k < 2; ++k) { const int idx = tid + 512 * k; *(S5_LAS u32x4*)(lds + OFF_KT + idx * 16) = kv2[k]; }
    }
    __syncthreads();
    {
        f32x4 a1[4];
#pragma unroll
        for (int cb = 0; cb < 4; ++cb) a1[cb] = (f32x4){0.f, 0.f, 0.f, 0.f};
#pragma unroll
        for (int ks = 0; ks < 16; ++ks)
#pragma unroll
            for (int cb = 0; cb < 4; ++cb) { const bf16x8 bfr = *(const S5_LAS bf16x8*)(lds + OFF_UB + (16 * cb + i) * UB_STR + 64 * ks + 16 * gq);
                a1[cb] = __builtin_amdgcn_mfma_f32_16x16x32_bf16(pa[ks], bfr, a1[cb], 0, 0, 0); }
#pragma unroll
        for (int cb = 0; cb < 4; ++cb) *(S5_LAS f32x4*)(lds + OFF_SC + ((16 * cb + i) * 128 + 16 * w + 4 * gq) * 4) = a1[cb];
    }
    const int t0 = w, t1 = 15 - w, t2 = 16 + w, t3 = 31 - w;
    bf16x8 qa[4][4];
#pragma unroll
    for (int tt = 0; tt < 4; ++tt) { const int t = (tt == 0) ? t0 : (tt == 1) ? t1 : (tt == 2) ? t2 : t3;
#pragma unroll
        for (int k2 = 0; k2 < 4; ++k2) qa[tt][k2] = *(const bf16x8*)(QMg + (size_t)(t * 16 + i) * 128 + 32 * k2 + 8 * gq); }
    __syncthreads();
    if (w == 0) {
        const float ar = ALg[lane * 2], ai = ALg[lane * 2 + 1]; float xr = 0.f, xi = 0.f;
        float sre[2][8], sim[2][8];
#define S5_SLD(bt, c0) do { _Pragma("unroll") for (int j_ = 0; j_ < 8; ++j_) { sre[bt][j_] = *(const S5_LAS float*)(lds + OFF_SC + (((c0) + j_) * 128 + lane) * 4); sim[bt][j_] = *(const S5_LAS float*)(lds + OFF_SC + (((c0) + j_) * 128 + 64 + lane) * 4); } } while (0)
#define S5_SSTEP(bt, c0) do { _Pragma("unroll") for (int j_ = 0; j_ < 8; ++j_) { const int c_ = (c0) + j_; \
            *(S5_LAS unsigned short*)(lds + OFF_XB + c_ * XB_STR + lane * 2) = f2bf_(xr); *(S5_LAS unsigned short*)(lds + OFF_XB + c_ * XB_STR + 128 + lane * 2) = f2bf_(xi); \
            const float nxr_ = ar * xr - ai * xi + sre[bt][j_], nxi_ = ar * xi + ai * xr + sim[bt][j_]; xr = nxr_; xi = nxi_; } } while (0)
        S5_SLD(0, 0);
#pragma unroll 1
        for (int c0 = 0; c0 < 64; c0 += 16) {
            S5_SLD(1, c0 + 8); S5_SSTEP(0, c0);
            if (c0 + 16 < 64) S5_SLD(0, c0 + 16);
            S5_SSTEP(1, c0 + 8);
        }
#undef S5_SLD
#undef S5_SSTEP
    }
    f32x4 acc[4][4];
#pragma unroll
    for (int tt = 0; tt < 4; ++tt)
#pragma unroll
        for (int cb = 0; cb < 4; ++cb) acc[tt][cb] = (f32x4){0.f, 0.f, 0.f, 0.f};
#pragma unroll 2
    for (int ks = 0; ks < 16; ++ks) {
        if (2 * ks > t3) break;
        bf16x8 bfr[4];
#pragma unroll
        for (int cb = 0; cb < 4; ++cb) bfr[cb] = *(const S5_LAS bf16x8*)(lds + OFF_UB + (16 * cb + i) * UB_STR + 64 * ks + 16 * gq);
        const int s = 2 * ks + (gq >> 1);
#pragma unroll
        for (int tt = 0; tt < 4; ++tt) { const int t = (tt == 0) ? t0 : (tt == 1) ? t1 : (tt == 2) ? t2 : t3;
            if (2 * ks <= t) {
                const int tau = t - s; bf16x8 af = (bf16x8){0, 0, 0, 0, 0, 0, 0, 0};
                if (tau >= 0) af = *(const S5_LAS bf16x8*)(lds + OFF_KT + ((tau * 16 + i) * 16 + 8 * (gq & 1)) * 2);
#pragma unroll
                for (int cb = 0; cb < 4; ++cb) acc[tt][cb] = __builtin_amdgcn_mfma_f32_16x16x32_bf16(af, bfr[cb], acc[tt][cb], 0, 0, 0);
            } }
    }
    __syncthreads();
#pragma unroll
    for (int k2 = 0; k2 < 4; ++k2) {
        bf16x8 bfr[4];
#pragma unroll
        for (int cb = 0; cb < 4; ++cb) bfr[cb] = *(const S5_LAS bf16x8*)(lds + OFF_XB + (16 * cb + i) * XB_STR + 64 * k2 + 16 * gq);
#pragma unroll
        for (int tt = 0; tt < 4; ++tt)
#pragma unroll
            for (int cb = 0; cb < 4; ++cb) acc[tt][cb] = __builtin_amdgcn_mfma_f32_16x16x32_bf16(qa[tt][k2], bfr[cb], acc[tt][cb], 0, 0, 0);
    }
    const f32x4 dv = *(const f32x4*)(dsk + 4 * gq);
#pragma unroll
    for (int tt = 0; tt < 4; ++tt) { const int t = (tt == 0) ? t0 : (tt == 1) ? t1 : (tt == 2) ? t2 : t3;
#pragma unroll
        for (int cb = 0; cb < 4; ++cb) { const int c = 16 * cb + i;
            const u32x2 uw = *(const S5_LAS u32x2*)(lds + OFF_UB + c * UB_STR + (t * 16 + 4 * gq) * 2);
            const float u0 = __uint_as_float(uw.x << 16), u1 = __uint_as_float(uw.x & 0xffff0000u), u2 = __uint_as_float(uw.y << 16), u3 = __uint_as_float(uw.y & 0xffff0000u);
            const float y0 = gelu_tanh(acc[tt][cb][0] + dv[0] * u0), y1 = gelu_tanh(acc[tt][cb][1] + dv[1] * u1), y2 = gelu_tanh(acc[tt][cb][2] + dv[2] * u2), y3 = gelu_tanh(acc[tt][cb][3] + dv[3] * u3);
            u32x2 ow; ow.x = (unsigned)f2bf_(y0) | ((unsigned)f2bf_(y1) << 16); ow.y = (unsigned)f2bf_(y2) | ((unsigned)f2bf_(y3) << 16);
            *(u32x2*)(Gout + (size_t)(c * 32 + t) * 512 + 4 * gq) = ow; } }
    __syncthreads();
}
#undef S5_LAS
}
namespace retf {
typedef float f32x4 __attribute__((ext_vector_type(4)));
typedef float f32x2 __attribute__((ext_vector_type(2)));
typedef short bf16x8 __attribute__((ext_vector_type(8)));
typedef short s16x4 __attribute__((ext_vector_type(4)));
typedef short v4i16_t __attribute__((ext_vector_type(4)));
typedef unsigned u32x4 __attribute__((ext_vector_type(4)));
#define RT_LAS __attribute__((address_space(3)))
constexpr int STR = 288, OFF_KP = 0, OFF_VP = 128 * STR, OFF_RP = 256 * STR, LDS_NEED = 384 * STR;
typedef float cvf32x2_t __attribute__((ext_vector_type(2))); typedef __bf16 cvbf16x2_t __attribute__((ext_vector_type(2)));
__device__ __forceinline__ unsigned cvtpk(float lo, float hi) { const cvf32x2_t v = {lo, hi}; const cvbf16x2_t b = __builtin_convertvector(v, cvbf16x2_t); return __builtin_bit_cast(unsigned, b); }
__device__ __forceinline__ s16x4 vtr(const RT_LAS unsigned char* p) { return __builtin_bit_cast(s16x4, __builtin_amdgcn_ds_read_tr16_b64_v4i16((RT_LAS v4i16_t*)p)); }
__device__ __forceinline__ float blo(unsigned w) { return __uint_as_float(w << 16); }
__device__ __forceinline__ float bhi(unsigned w) { return __uint_as_float(w & 0xffff0000u); }
__device__ __forceinline__ unsigned short f2bf_(float f) { unsigned u = __builtin_bit_cast(unsigned, f); return (unsigned short)((u + 0x7fffu + ((u >> 16) & 1u)) >> 16); }
__device__ __forceinline__ void rot8(const u32x4 a, const u32x4 b, const f32x2* cs, float sc, u32x4& r1, u32x4& r2) {
    float x1[8] = {blo(a.x), bhi(a.x), blo(a.y), bhi(a.y), blo(a.z), bhi(a.z), blo(a.w), bhi(a.w)}, x2[8] = {blo(b.x), bhi(b.x), blo(b.y), bhi(b.y), blo(b.z), bhi(b.z), blo(b.w), bhi(b.w)};
    float o1[8], o2[8];
#pragma unroll
    for (int j = 0; j < 8; ++j) { o1[j] = (x1[j] * cs[j].x - x2[j] * cs[j].y) * sc; o2[j] = (x1[j] * cs[j].y + x2[j] * cs[j].x) * sc; }
    r1.x = cvtpk(o1[0], o1[1]); r1.y = cvtpk(o1[2], o1[3]); r1.z = cvtpk(o1[4], o1[5]); r1.w = cvtpk(o1[6], o1[7]);
    r2.x = cvtpk(o2[0], o2[1]); r2.y = cvtpk(o2[2], o2[3]); r2.z = cvtpk(o2[4], o2[5]); r2.w = cvtpk(o2[6], o2[7]);
}
__device__ __forceinline__ void unit(const unsigned short* pq, const unsigned short* pk, const unsigned short* pv, const unsigned short* pg, int ldp, const f32x2* rot, unsigned short* out, int ldo, int h, float eps, RT_LAS unsigned char* lds) {
    int tid_ = threadIdx.x; asm volatile("" : "+v"(tid_));
    const int tid = tid_, lane = tid & 63, w = __builtin_amdgcn_readfirstlane(tid >> 6), i = lane & 15, g = lane >> 4, q4 = (lane >> 2) & 3, p4 = lane & 3;
    const float gam = 1.f - exp2f(-5.f - (float)h), lg2 = log2f(gam), gC1 = exp2f(127.f * lg2);
    f32x4 Racc[8];
#pragma unroll
    for (int d = 0; d < 8; ++d) Racc[d] = (f32x4){0.f, 0.f, 0.f, 0.f};
    const RT_LAS unsigned char* trb = lds + q4 * STR + 8 * p4;
#pragma unroll 1
    for (int n = 0; n < 16; ++n) {
        u32x4 ka[2], kb[2], va[4], qa_[2], qb_[2]; f32x4 kr[2][4], qr[2][4];
#pragma unroll
        for (int k = 0; k < 2; ++k) { const int idx = tid + 512 * k, s_ = idx >> 3, c = idx & 7; const size_t row = (size_t)(n * 128 + s_);
            ka[k] = *(const u32x4*)(pk + row * ldp + 8 * c); kb[k] = *(const u32x4*)(pk + row * ldp + 64 + 8 * c);
            const f32x4* rp = (const f32x4*)(rot + row * 64 + 8 * c);
#pragma unroll
            for (int j = 0; j < 4; ++j) kr[k][j] = rp[j]; }
#pragma unroll
        for (int k = 0; k < 4; ++k) { const int idx = tid + 512 * k, s_ = idx >> 4, c = idx & 15; va[k] = *(const u32x4*)(pv + (size_t)(n * 128 + s_) * ldp + 8 * c); }
        { const size_t row = (size_t)(n * 128 + 16 * w + i);
#pragma unroll
          for (int ks = 0; ks < 2; ++ks) { qa_[ks] = *(const u32x4*)(pq + row * ldp + 32 * ks + 8 * g); qb_[ks] = *(const u32x4*)(pq + row * ldp + 64 + 32 * ks + 8 * g);
              const f32x4* rp = (const f32x4*)(rot + row * 64 + 32 * ks + 8 * g);
#pragma unroll
              for (int j = 0; j < 4; ++j) qr[ks][j] = rp[j]; } }
#pragma unroll
        for (int k = 0; k < 2; ++k) { const int idx = tid + 512 * k, s_ = idx >> 3, c = idx & 7;
            f32x2 cs[8];
#pragma unroll
            for (int j = 0; j < 4; ++j) { const f32x4 t4 = kr[k][j]; cs[2 * j] = (f32x2){t4.x, t4.y}; cs[2 * j + 1] = (f32x2){t4.z, t4.w}; }
            u32x4 r1, r2; rot8(ka[k], kb[k], cs, 0.08838834764831845f * exp2f(-(float)s_ * lg2), r1, r2);
            *(RT_LAS u32x4*)(lds + OFF_KP + s_ * STR + 16 * c) = r1; *(RT_LAS u32x4*)(lds + OFF_KP + s_ * STR + 128 + 16 * c) = r2; }
#pragma unroll
        for (int k = 0; k < 4; ++k) { const int idx = tid + 512 * k, s_ = idx >> 4, c = idx & 15; *(RT_LAS u32x4*)(lds + OFF_VP + s_ * STR + 16 * c) = va[k]; }
        bf16x8 qf[4];
        { const float qsc = exp2f((float)(16 * w + i) * lg2);
#pragma unroll
          for (int ks = 0; ks < 2; ++ks) {
              f32x2 cs[8];
#pragma unroll
              for (int j = 0; j < 4; ++j) { const f32x4 t4 = qr[ks][j]; cs[2 * j] = (f32x2){t4.x, t4.y}; cs[2 * j + 1] = (f32x2){t4.z, t4.w}; }
              u32x4 r1, r2; rot8(qa_[ks], qb_[ks], cs, qsc, r1, r2); qf[ks] = __builtin_bit_cast(bf16x8, r1); qf[ks + 2] = __builtin_bit_cast(bf16x8, r2); } }
        __syncthreads();
        f32x4 O[8];
#pragma unroll
        for (int d = 0; d < 8; ++d) O[d] = (f32x4){0.f, 0.f, 0.f, 0.f};
        if (n > 0) {
            {
                s16x4 xlo[4], xhi[4];
#define RT_XLD(st_, sl_) do { xlo[sl_] = vtr(trb + OFF_RP + (32 * ((st_) >> 3) + 8 * g) * STR + 32 * ((st_) & 7)); xhi[sl_] = vtr(trb + OFF_RP + (32 * ((st_) >> 3) + 8 * g + 4) * STR + 32 * ((st_) & 7)); } while (0)
#pragma unroll
                for (int p = 0; p < 4; ++p) RT_XLD(p, p);
#pragma unroll
                for (int st = 0; st < 32; ++st) { const s16x4 lo = xlo[st & 3], hi = xhi[st & 3];
                    const bf16x8 rf = (bf16x8){lo[0], lo[1], lo[2], lo[3], hi[0], hi[1], hi[2], hi[3]};
                    if (st + 4 < 32) RT_XLD(st + 4, st & 3);
                    O[st & 7] = __builtin_amdgcn_mfma_f32_16x16x32_bf16(qf[st >> 3], rf, O[st & 7], 0, 0, 0); }
#undef RT_XLD
            }
#pragma unroll
            for (int d = 0; d < 8; ++d) O[d] = O[d] * gam;
        }
        bf16x8 pa[4];
        {
            f32x4 s[8];
#pragma unroll
            for (int blk = 0; blk < 8; ++blk) { s[blk] = (f32x4){0.f, 0.f, 0.f, 0.f};
                if (blk <= w) {
#pragma unroll
                    for (int ks = 0; ks < 4; ++ks) { const bf16x8 kf = *(const RT_LAS bf16x8*)(lds + OFF_KP + (16 * blk + i) * STR + 64 * ks + 16 * g);
                        s[blk] = __builtin_amdgcn_mfma_f32_16x16x32_bf16(kf, qf[ks], s[blk], 0, 0, 0); }
                    if (blk == w) {
#pragma unroll
                        for (int r = 0; r < 4; ++r) if (4 * g + r > i) s[blk][r] = 0.f;
                    }
                } }
#pragma unroll
            for (int s2 = 0; s2 < 4; ++s2) { u32x4 wv; wv.x = cvtpk(s[2 * s2][0], s[2 * s2][1]); wv.y = cvtpk(s[2 * s2][2], s[2 * s2][3]); wv.z = cvtpk(s[2 * s2 + 1][0], s[2 * s2 + 1][1]); wv.w = cvtpk(s[2 * s2 + 1][2], s[2 * s2 + 1][3]);
                pa[s2] = __builtin_bit_cast(bf16x8, wv); }
        }
#pragma unroll
        for (int s2 = 0; s2 < 4; ++s2)
            if (2 * s2 <= w) {
                s16x4 plo[4], phi[4];
#define RT_PLD(d_, sl_) do { plo[sl_] = vtr(trb + OFF_VP + (32 * s2 + 4 * g) * STR + 32 * (d_)); phi[sl_] = vtr(trb + OFF_VP + (32 * s2 + 16 + 4 * g) * STR + 32 * (d_)); } while (0)
#pragma unroll
                for (int p = 0; p < 4; ++p) RT_PLD(p, p);
#pragma unroll
                for (int d = 0; d < 8; ++d) { const s16x4 lo = plo[d & 3], hi = phi[d & 3];
                    const bf16x8 vf = (bf16x8){lo[0], lo[1], lo[2], lo[3], hi[0], hi[1], hi[2], hi[3]};
                    if (d + 4 < 8) RT_PLD(d + 4, d & 3);
                    O[d] = __builtin_amdgcn_mfma_f32_16x16x32_bf16(pa[s2], vf, O[d], 0, 0, 0); }
#undef RT_PLD
            }
        {
            float ss[4] = {0.f, 0.f, 0.f, 0.f};
#pragma unroll
            for (int d = 0; d < 8; ++d)
#pragma unroll
                for (int r = 0; r < 4; ++r) ss[r] += O[d][r] * O[d][r];
            unsigned short gtv[4][8];
#pragma unroll
            for (int r = 0; r < 4; ++r) { const size_t row = (size_t)(n * 128 + 16 * w + 4 * g + r);
#pragma unroll
                for (int d = 0; d < 8; ++d) gtv[r][d] = pg[row * ldp + 16 * d + i]; }
#pragma unroll
            for (int r = 0; r < 4; ++r) {
                { float v_ = ss[r];
                  v_ += __builtin_bit_cast(float, __builtin_amdgcn_update_dpp(0, __builtin_bit_cast(int, v_), 0xB1, 0xF, 0xF, true)); v_ += __builtin_bit_cast(float, __builtin_amdgcn_update_dpp(0, __builtin_bit_cast(int, v_), 0x4E, 0xF, 0xF, true));
                  v_ += __builtin_bit_cast(float, __builtin_amdgcn_update_dpp(0, __builtin_bit_cast(int, v_), 0x124, 0xF, 0xF, true)); v_ += __builtin_bit_cast(float, __builtin_amdgcn_update_dpp(0, __builtin_bit_cast(int, v_), 0x128, 0xF, 0xF, true));
                  ss[r] = v_; } }
#pragma unroll
            for (int r = 0; r < 4; ++r)
#pragma unroll
                for (int d = 0; d < 8; ++d) asm volatile("" : "+v"(gtv[r][d]));
#pragma unroll
            for (int r = 0; r < 4; ++r) {
                const float rs = 1.0f / sqrtf(ss[r] * (1.f / 128.f) + eps);
                const size_t row = (size_t)(n * 128 + 16 * w + 4 * g + r);
#pragma unroll
                for (int d = 0; d < 8; ++d) { const float gt = __uint_as_float((unsigned)gtv[r][d] << 16);
                    out[row * ldo + 16 * d + i] = f2bf_(O[d][r] * rs * (gt / (1.f + __expf(-gt)))); }
            }
        }
        if (n < 15) {
#pragma unroll
            for (int d = 0; d < 8; ++d) Racc[d] = Racc[d] * gam;
            {
                bf16x8 kt[4];
#pragma unroll
                for (int ks = 0; ks < 4; ++ks) { const s16x4 klo = vtr(trb + OFF_KP + (32 * ks + 8 * g) * STR + 32 * w), khi = vtr(trb + OFF_KP + (32 * ks + 8 * g + 4) * STR + 32 * w);
                    kt[ks] = (bf16x8){klo[0], klo[1], klo[2], klo[3], khi[0], khi[1], khi[2], khi[3]}; }
                s16x4 ulo[4], uhi[4];
#define RT_ULD(st_, sl_) do { ulo[sl_] = vtr(trb + OFF_VP + (32 * ((st_) >> 3) + 8 * g) * STR + 32 * ((st_) & 7)); uhi[sl_] = vtr(trb + OFF_VP + (32 * ((st_) >> 3) + 8 * g + 4) * STR + 32 * ((st_) & 7)); } while (0)
#pragma unroll
                for (int p = 0; p < 4; ++p) RT_ULD(p, p);
#pragma unroll
                for (int st = 0; st < 32; ++st) { const s16x4 lo = ulo[st & 3], hi = uhi[st & 3];
                    const bf16x8 vf = (bf16x8){lo[0], lo[1], lo[2], lo[3], hi[0], hi[1], hi[2], hi[3]};
                    if (st + 4 < 32) RT_ULD(st + 4, st & 3);
                    Racc[st & 7] = __builtin_amdgcn_mfma_f32_16x16x32_bf16(kt[st >> 3], vf, Racc[st & 7], 0, 0, 0); }
#undef RT_ULD
            }
#pragma unroll
            for (int d = 0; d < 8; ++d) Racc[d] = Racc[d] * gC1;
        }
        __syncthreads();
        if (n < 15) {
#pragma unroll
            for (int d = 0; d < 8; ++d)
#pragma unroll
                for (int r = 0; r < 4; ++r) *(RT_LAS unsigned short*)(lds + OFF_RP + (16 * w + 4 * g + r) * STR + (16 * d + i) * 2) = f2bf_(Racc[d][r]);
        }
    }
    __syncthreads();
}
#undef RT_LAS
}

#ifndef PG8_SP2
#define PG8_SP2 true
#endif
#ifndef PG8_ALIGN
#define PG8_ALIGN true
#endif
constexpr int NWAVES = 8;
#ifndef MK_ONE_LAUNCH
#define MK_ONE_LAUNCH 1
#endif

constexpr int BATCH = 16, SEQ = 2048, DM = 2048, T = BATCH * SEQ, DEPTH = 2, MEMLEN = 256, TMEM = BATCH * MEMLEN;
constexpr int INW = 5632, INWP = 2560, DFF = 8192, XW = 512;
constexpr int C_RQ = 0, C_RK = 512, C_RV = 1024, C_RG = 1536, C_SU = 2048, C_DQ = 2560, C_DK = 3584, C_DV = 4608;
constexpr int RET_H = 4, S5_G = 32, S5_P = 64, DIFF_H = 8, X_H = 4;
constexpr float EPS = 1e-6f;
#ifndef MLP_SPLIT
#define MLP_SPLIT 4
#endif
constexpr int MLP_ROWS = T / MLP_SPLIT;
constexpr int NPH_LAYER = 11 + MLP_SPLIT, NPHASES = 1 + DEPTH * NPH_LAYER;

constexpr size_t MiB = 1u << 20;
constexpr size_t WS_CTL = 0, CTL_ZERO_BYTES = 1 * MiB;
constexpr size_t WS_TAB = 1 * MiB;
constexpr size_t WS_ROT = 2 * MiB;
constexpr size_t WS_MEMN = 18 * MiB;
constexpr size_t WS_KVX = 34 * MiB;
constexpr size_t WS_S5C = 42 * MiB;
constexpr size_t WS_WIN = 66 * MiB, WS_WOUT = 88 * MiB, WS_WGLU = 96 * MiB, WS_WXQ = 97 * MiB, WS_WXKV = 99 * MiB, WS_WXO = 103 * MiB, WS_WUP = 105 * MiB, WS_WDN = 137 * MiB;
constexpr size_t WS_XB = 169 * MiB;
constexpr size_t WS_RS = 1 * MiB + 65536, WS_RSM = 1 * MiB + 65536 + 262144;
constexpr size_t WS_WL1 = 231 * MiB;
constexpr size_t WS_Y = (617 + 128) * MiB;
constexpr size_t WS_MIXED = 425 * MiB;
constexpr size_t WS_G = 553 * MiB;
constexpr size_t WS_QX = 585 * MiB;
constexpr size_t WS_PROJ = 617 * MiB;
constexpr size_t WS_DSEC = WS_PROJ + 160 * MiB;
constexpr size_t WS_END = 969 * MiB;
static_assert(WS_PROJ + (size_t)T * INW * 2 <= WS_END && (size_t)(T / 4) * DFF * 2 <= (size_t)T * INW * 2 && (size_t)T * INWP * 2 == 160 * MiB, "d_ws map");
constexpr int CW_TMO = 0, CW_CODE = 1;
constexpr int CW_BAR = 4096;
constexpr int CW_QUEUE = 16384;

constexpr int RING_OFF = 0, RING_BYTES = 131072;
constexpr int LDSCTL_OFF = 162816, MISC_OFF = LDSCTL_OFF + 320;
constexpr int LDS_BYTES = 163840;
static_assert(MISC_OFF + 128 <= LDS_BYTES, "LDS map");

#define GAS __attribute__((address_space(1)))
#define LAS __attribute__((address_space(3)))
typedef unsigned short bf16;
typedef unsigned v4u __attribute__((ext_vector_type(4)));
typedef unsigned v2u __attribute__((ext_vector_type(2)));
typedef float f32x4 __attribute__((ext_vector_type(4)));
typedef float f32x2 __attribute__((ext_vector_type(2)));
typedef short bf16x8 __attribute__((ext_vector_type(8)));
typedef GAS unsigned gu32;
typedef GAS unsigned long long gu64;
#define RLX_AGENT __ATOMIC_RELAXED, __HIP_MEMORY_SCOPE_AGENT
#define LDS_WAIT() asm volatile("s_waitcnt lgkmcnt(0)" ::: "memory")
#define VM_WAIT() asm volatile("s_waitcnt vmcnt(0)" ::: "memory")
__device__ __forceinline__ unsigned f2bf(float f) { unsigned u = __builtin_bit_cast(unsigned, f); return (u + 0x7fffu + ((u >> 16) & 1u)) >> 16; }
__device__ __forceinline__ unsigned pk2(float lo, float hi) { return f2bf(lo) | (f2bf(hi) << 16); }
__device__ __forceinline__ float bf2f(bf16 b) { return __uint_as_float((unsigned)b << 16); }
__device__ __forceinline__ float bflo(unsigned w) { return __uint_as_float(w << 16); }
__device__ __forceinline__ float bfhi(unsigned w) { return __uint_as_float(w & 0xffff0000u); }

#define XB_TMO      128
#define XB_XCNT(j)  (256  + 64 * (j))
#define XB_XSUB(j)  (1280 + 64 * (j))
#define XB_XGEN(j)  (2304 + 64 * (j))
#define XB_TOP      3328
#define XB_TOPGEN   3392
#define XCD_BAR_WORDS 3456
#define XB_SPIN_CAP (1u << 21)

__device__ __forceinline__ unsigned xb_ld(unsigned* p)              { return __hip_atomic_load(p, __ATOMIC_RELAXED, __HIP_MEMORY_SCOPE_AGENT); }
__device__ __forceinline__ unsigned xb_add(unsigned* p, unsigned v) { return __hip_atomic_fetch_add(p, v, __ATOMIC_RELAXED, __HIP_MEMORY_SCOPE_AGENT); }
__device__ __forceinline__ unsigned xb_xcc_id() { return (unsigned)__builtin_amdgcn_s_getreg((3 << 11) | 20) & 0xFu; }
#define XB_SPIN(cond, bar) do { unsigned _sp = 0; while (cond) { __builtin_amdgcn_s_sleep(1); \
    if ((++_sp & 255u) == 0u) { if (xb_ld(&(bar)[XB_TMO])) break; if (_sp > XB_SPIN_CAP) { atomicAdd(&(bar)[XB_TMO], 1u); break; } } } } while (0)

struct XcdBarrier {
    unsigned* bar; unsigned x;
    volatile LAS unsigned* st;
};

__device__ __forceinline__ XcdBarrier xcd_barrier_post(unsigned* bar, volatile LAS unsigned* st) {
    XcdBarrier b; b.bar = bar; b.x = xb_xcc_id(); b.st = st;
    if (threadIdx.x == 0) (void)xb_add(&bar[XB_XCNT(b.x)], 1u);
    return b;
}
__device__ __forceinline__ void xcd_barrier_complete(unsigned* bar, unsigned x, unsigned& nloc, unsigned& nx) {
    const unsigned G = gridDim.x * gridDim.y * gridDim.z;
    unsigned sum, cnt, mine, sp = 0u;
    for (;;) {
        sum = 0u; cnt = 0u; mine = 0u;
#pragma unroll
        for (unsigned j = 0; j < 16; ++j) { const unsigned c = xb_ld(&bar[XB_XCNT(j)]); sum += c; cnt += (c > 0u) ? 1u : 0u; mine = (j == x) ? c : mine; }
        if (sum == G) break;
        __builtin_amdgcn_s_sleep(1);
        if ((++sp & 255u) == 0u) { if (xb_ld(&bar[XB_TMO])) break; if (sp > XB_SPIN_CAP) { atomicAdd(&bar[XB_TMO], 1u); break; } }
    }
    nloc = mine > 0u ? mine : 1u; nx = cnt > 0u ? cnt : 1u;
}

__device__ __forceinline__ void xcd_barrier(const XcdBarrier& b) {
    asm volatile("s_waitcnt vmcnt(0)" ::: "memory");
    __syncthreads();
    if (threadIdx.x == 0) {
        unsigned* bar = b.bar;
        __builtin_amdgcn_s_waitcnt(0);
        unsigned nloc = b.st[0], nx = b.st[1];
        if (nloc == 0u) { xcd_barrier_complete(bar, b.x, nloc, nx); b.st[0] = nloc; b.st[1] = nx; }
        const unsigned old = xb_add(&bar[XB_XSUB(b.x)], 1u);
        const unsigned gen = old / nloc;
        if (old + 1u == (gen + 1u) * nloc) {
            __builtin_amdgcn_fence(__ATOMIC_RELEASE, "agent");
            asm volatile("s_waitcnt vmcnt(0)" ::: "memory");
            const unsigned og = xb_add(&bar[XB_TOP], 1u);
            const unsigned tg = og / nx;
            if (og + 1u == (tg + 1u) * nx) xb_add(&bar[XB_TOPGEN], 1u);
            else XB_SPIN(xb_ld(&bar[XB_TOPGEN]) == tg, bar);
            __builtin_amdgcn_fence(__ATOMIC_ACQUIRE, "agent");
            xb_add(&bar[XB_XGEN(b.x)], 1u);
            asm volatile("s_waitcnt vmcnt(0)" ::: "memory");
        } else {
            XB_SPIN(xb_ld(&bar[XB_XGEN(b.x)]) == gen, bar);
            __builtin_amdgcn_fence(__ATOMIC_ACQUIRE, "agent");
            asm volatile("s_waitcnt vmcnt(0)" ::: "memory");
        }
    }
    __syncthreads();
}


struct Frame {
    LAS unsigned char* lds;
    volatile LAS unsigned* MISC;
    gu32* ctl;
    int tid, lane, wave;
    int vcu, G;
    float* out; unsigned char* ws;
};
struct Args { const float* in[32]; float* out; unsigned char* ws; int ph_lo, ph_hi, use_bar, pad; };
#define FIN(i) (A.in[i])
enum { I_X = 0, I_MEM, I_POS, I_RELB, I_WIN, I_WOUT, I_LAMRE, I_LAMIM, I_LOGDT, I_BRE, I_BIM, I_CRE, I_CIM, I_DSKIP, I_WGLU, I_LQ1, I_LK1, I_LQ2, I_LK2, I_GSUB,
       I_WXQ, I_WXKV, I_WXO, I_WUP, I_WDN, I_GMIXPRE, I_GMIXPOST, I_GMEM, I_GXPRE, I_GXPOST, I_GMLPPRE, I_GMLPPOST };

__device__ __forceinline__ int launder_s(int v) { asm volatile("" : "+s"(v)); return v; }
#define WS_DPP(v, ctrl) __builtin_bit_cast(float, __builtin_amdgcn_update_dpp(0, __builtin_bit_cast(int, (v)), (ctrl), 0xF, 0xF, true))
__device__ __forceinline__ float wave_sum(float v) {
    v += WS_DPP(v, 0xB1);
    v += WS_DPP(v, 0x4E);
    v += WS_DPP(v, 0x124);
    v += WS_DPP(v, 0x128);
    v += __shfl_xor(v, 16); v += __shfl_xor(v, 32);
    return v;
}
__device__ __forceinline__ float wave_max(float v) {
#pragma unroll
    for (int o = 1; o < 64; o <<= 1) v = fmaxf(v, __shfl_xor(v, o));
    return v;
}
__device__ __forceinline__ void sincos_acc(double ang, float& s, float& c) {
    const double q = __builtin_rint(ang * 0.63661977236758134308);
    const float r = (float)__builtin_fma(-q, 1.57079632679489661923, ang);
    const int qi = ((int)q) & 3;
    const float r2 = r * r;
    const float sr = r * (1.f + r2 * (-1.6666667e-1f + r2 * (8.3333333e-3f + r2 * (-1.9841270e-4f + r2 * 2.7557319e-6f))));
    const float cr = 1.f + r2 * (-0.5f + r2 * (4.1666667e-2f + r2 * (-1.3888889e-3f + r2 * (2.4801587e-5f + r2 * (-2.7557319e-7f)))));
    s = (qi == 0) ? sr : (qi == 1) ? cr : (qi == 2) ? -sr : -cr;
    c = (qi == 0) ? cr : (qi == 1) ? -sr : (qi == 2) ? -cr : sr;
}

constexpr int TR_PITCH = 68, TR_BYTES = 64 * TR_PITCH * 4;
__device__ __forceinline__ void transpose_item(const float* W, const float* gain, int K, int N, bf16* WT, LAS float* scr, int item, int lane) {
    const int nblk = N / 64, kb = item / nblk, nb = item % nblk, k0 = 64 * kb, n0 = 64 * nb;
    const int kr = lane >> 4, nc = 4 * (lane & 15);
    f32x4 v[16];
#pragma unroll
    for (int i = 0; i < 16; ++i) v[i] = *(const GAS f32x4*)(W + (size_t)(k0 + 4 * i + kr) * N + n0 + nc);
    float gg[16];
#pragma unroll
    for (int i = 0; i < 16; ++i) gg[i] = gain ? gain[k0 + 4 * i + kr] : 1.f;
#pragma unroll
    for (int i = 0; i < 16; ++i) asm volatile("" : "+v"(gg[i]));
#pragma unroll
    for (int i = 0; i < 16; ++i) *(LAS f32x4*)(scr + (4 * i + kr) * TR_PITCH + nc) = v[i] * gg[i];
    LDS_WAIT(); asm volatile("" ::: "memory");
#pragma unroll
    for (int j = 0; j < 8; ++j) { const int idx = lane + 64 * j, n = idx >> 3, c = idx & 7; const LAS float* s = scr + (8 * c) * TR_PITCH + n;
        v4u o; o.x = pk2(s[0 * TR_PITCH], s[1 * TR_PITCH]); o.y = pk2(s[2 * TR_PITCH], s[3 * TR_PITCH]); o.z = pk2(s[4 * TR_PITCH], s[5 * TR_PITCH]); o.w = pk2(s[6 * TR_PITCH], s[7 * TR_PITCH]);
        const int nn = n0 + n, x = nn & 31, rho = (nn & ~31) + ((x >> 2) & 1) * 16 + ((x >> 3) << 2) + (x & 3), kk = k0 + 8 * c;
        *(GAS v4u*)(WT + ((size_t)((rho >> 4) * (K / 32) + (kk >> 5)) * 512 + (rho & 15) * 32 + (kk & 31))) = o; }
    LDS_WAIT(); asm volatile("" ::: "memory");
}
__device__ __forceinline__ void convert_weights(Frame& F, const Args& A, int l, int gw, int NGW, int part_lo, int part_hi) {
    LAS float* scr = (LAS float*)(F.lds + RING_OFF + F.wave * TR_BYTES);
    constexpr int I_IN = (DM / 64) * (INW / 64), I_OUT = (DM / 64) * (DM / 64), I_GLU = (512 / 64) * (512 / 64), I_XQ = (DM / 64) * (XW / 64), I_XKV = (DM / 64) * (2 * XW / 64),
                  I_XO = (XW / 64) * (DM / 64), I_UP = (DM / 64) * (DFF / 64), I_DN = (DFF / 64) * (DM / 64);
    constexpr int NITEMS = I_IN + I_OUT + I_GLU + I_XQ + I_XKV + I_XO + I_UP + I_DN;
    unsigned char* ws = F.ws + (size_t)l * WS_WL1;
    constexpr int I_HEAD = I_IN + I_OUT + I_GLU + I_XQ + I_XKV + I_XO;
    const int it_lo = part_lo == 0 ? 0 : I_HEAD, it_hi = part_hi == 0 ? I_HEAD : NITEMS;
    for (int it = it_lo + gw; it < it_hi; it += NGW) {
        int r = it;
        if (r < I_IN) { transpose_item(A.in[I_WIN] + (size_t)l * DM * INW, A.in[I_GMIXPRE] + l * DM, DM, INW, (bf16*)(ws + WS_WIN), scr, r, F.lane); continue; } r -= I_IN;
        if (r < I_OUT) { transpose_item(A.in[I_WOUT] + (size_t)l * DM * DM, nullptr, DM, DM, (bf16*)(ws + WS_WOUT), scr, r, F.lane); continue; } r -= I_OUT;
        if (r < I_GLU) { transpose_item(A.in[I_WGLU] + (size_t)l * 512 * 512, nullptr, 512, 512, (bf16*)(ws + WS_WGLU), scr, r, F.lane); continue; } r -= I_GLU;
        if (r < I_XQ) { transpose_item(A.in[I_WXQ] + (size_t)l * DM * XW, A.in[I_GXPRE] + l * DM, DM, XW, (bf16*)(ws + WS_WXQ), scr, r, F.lane); continue; } r -= I_XQ;
        if (r < I_XKV) { transpose_item(A.in[I_WXKV] + (size_t)l * DM * 2 * XW, A.in[I_GMEM] + l * DM, DM, 2 * XW, (bf16*)(ws + WS_WXKV), scr, r, F.lane); continue; } r -= I_XKV;
        if (r < I_XO) { transpose_item(A.in[I_WXO] + (size_t)l * XW * DM, nullptr, XW, DM, (bf16*)(ws + WS_WXO), scr, r, F.lane); continue; } r -= I_XO;
        if (r < I_UP) { transpose_item(A.in[I_WUP] + (size_t)l * DM * DFF, A.in[I_GMLPPRE] + l * DM, DM, DFF, (bf16*)(ws + WS_WUP), scr, r, F.lane); continue; } r -= I_UP;
        transpose_item(A.in[I_WDN] + (size_t)l * DFF * DM, nullptr, DFF, DM, (bf16*)(ws + WS_WDN), scr, r, F.lane);
    }
}
__device__ __forceinline__ void row_finish(const float (&v)[4][8], bf16* xo, float* rs, float* fo, int lane) {
    float s2 = 0.f;
#pragma unroll
    for (int j = 0; j < 4; ++j)
#pragma unroll
        for (int e = 0; e < 8; ++e) s2 += v[j][e] * v[j][e];
    if (rs) { const float r = 1.0f / sqrtf(wave_sum(s2) * (1.f / DM) + EPS); if (lane == 0) *rs = r; }
    if (xo) { GAS v4u* o = (GAS v4u*)xo + lane;
#pragma unroll
        for (int j = 0; j < 4; ++j) { v4u w; w.x = pk2(v[j][0], v[j][1]); w.y = pk2(v[j][2], v[j][3]); w.z = pk2(v[j][4], v[j][5]); w.w = pk2(v[j][6], v[j][7]); o[64 * j] = w; } }
    if (fo) { GAS f32x4* o = (GAS f32x4*)fo + 2 * lane;
#pragma unroll
        for (int j = 0; j < 4; ++j) { o[128 * j] = (f32x4){v[j][0], v[j][1], v[j][2], v[j][3]}; o[128 * j + 1] = (f32x4){v[j][4], v[j][5], v[j][6], v[j][7]}; } }
}
__device__ __forceinline__ void unpack8(const v4u w, float (&o)[8]) { o[0] = bflo(w.x); o[1] = bfhi(w.x); o[2] = bflo(w.y); o[3] = bfhi(w.y); o[4] = bflo(w.z); o[5] = bfhi(w.z); o[6] = bflo(w.w); o[7] = bfhi(w.w); }
constexpr int RB = 2;
template <int RB>
__device__ __forceinline__ void resnorm_rows(const bf16* xrow0, const bf16* yrow0, size_t rstep, const f32x4 (&gv)[8], bf16* xo0, float* rs0, float* fo0, size_t rs_step, int lane) {
    v4u xw[RB][4], yw[RB][4];
#pragma unroll
    for (int r = 0; r < RB; ++r) { const GAS v4u* xr = (const GAS v4u*)(xrow0 + r * rstep) + lane; const GAS v4u* yr = (const GAS v4u*)(yrow0 + r * rstep) + lane;
#pragma unroll
        for (int j = 0; j < 4; ++j) { xw[r][j] = xr[64 * j]; yw[r][j] = yr[64 * j]; } }
#pragma unroll
    for (int r = 0; r < RB; ++r) {
        float v[4][8], y[4][8]; float s = 0.f;
#pragma unroll
        for (int j = 0; j < 4; ++j) { unpack8(xw[r][j], v[j]); unpack8(yw[r][j], y[j]);
#pragma unroll
            for (int e = 0; e < 8; ++e) s += y[j][e] * y[j][e]; }
        const float ry = 1.0f / sqrtf(wave_sum(s) * (1.f / DM) + EPS);
#pragma unroll
        for (int j = 0; j < 4; ++j) { const f32x4 g0 = gv[2 * j], g1 = gv[2 * j + 1];
            v[j][0] += y[j][0] * ry * g0.x; v[j][1] += y[j][1] * ry * g0.y; v[j][2] += y[j][2] * ry * g0.z; v[j][3] += y[j][3] * ry * g0.w;
            v[j][4] += y[j][4] * ry * g1.x; v[j][5] += y[j][5] * ry * g1.y; v[j][6] += y[j][6] * ry * g1.z; v[j][7] += y[j][7] * ry * g1.w; }
        row_finish(v, xo0 ? xo0 + r * rstep : nullptr, rs0 ? rs0 + r * rs_step : nullptr, fo0 ? fo0 + r * rstep : nullptr, lane);
    }
}
template <int RB>
__device__ __forceinline__ void f32rows_to_bf(const float* xrow0, size_t rstep, bf16* xo0, float* rs0, size_t rs_step, int lane) {
    f32x4 xw[RB][8];
#pragma unroll
    for (int r = 0; r < RB; ++r) { const GAS f32x4* xr = (const GAS f32x4*)(xrow0 + r * rstep) + 2 * lane;
#pragma unroll
        for (int j = 0; j < 4; ++j) { xw[r][2 * j] = xr[128 * j]; xw[r][2 * j + 1] = xr[128 * j + 1]; } }
#pragma unroll
    for (int r = 0; r < RB; ++r) { float v[4][8];
#pragma unroll
        for (int j = 0; j < 4; ++j) { const f32x4 a = xw[r][2 * j], b = xw[r][2 * j + 1]; v[j][0] = a.x; v[j][1] = a.y; v[j][2] = a.z; v[j][3] = a.w; v[j][4] = b.x; v[j][5] = b.y; v[j][6] = b.z; v[j][7] = b.w; }
        row_finish(v, xo0 + r * rstep, rs0 + r * rs_step, nullptr, lane); }
}
__device__ __forceinline__ void resnorm_phase(Frame& F, const bf16* XBin, const bf16* Y, const float* gpost, bf16* XBout, float* RS, float* fout) {
    const int gw = F.vcu * NWAVES + F.wave, NGW = F.G * NWAVES;
    f32x4 gv[8];
    { const GAS f32x4* gr = (const GAS f32x4*)gpost + 2 * F.lane;
#pragma unroll
      for (int j = 0; j < 4; ++j) { gv[2 * j] = gr[128 * j]; gv[2 * j + 1] = gr[128 * j + 1]; } }
    static_assert(T % RB == 0, "rows per step");
    int m = gw;
    for (; m + (RB - 1) * NGW < T; m += RB * NGW)
        resnorm_rows<RB>(XBin + (size_t)m * DM, Y + (size_t)m * DM, (size_t)NGW * DM, gv, XBout ? XBout + (size_t)m * DM : nullptr, RS ? RS + m : nullptr, fout ? fout + (size_t)m * DM : nullptr, (size_t)NGW, F.lane);
    for (; m < T; m += NGW)
        resnorm_rows<1>(XBin + (size_t)m * DM, Y + (size_t)m * DM, 0, gv, XBout ? XBout + (size_t)m * DM : nullptr, RS ? RS + m : nullptr, fout ? fout + (size_t)m * DM : nullptr, 0, F.lane);
}
__device__ __forceinline__ void prologue_misc(Frame& F, const Args& A) {
    const int gt = (F.vcu * NWAVES + F.wave) * 64 + F.lane, NGT = F.G * NWAVES * 64;
    const int* pos = (const int*)A.in[I_POS];
    GAS f32x2* rot = (GAS f32x2*)(F.ws + WS_ROT);
    for (int i0 = gt; i0 < T * 64; i0 += 8 * NGT) {
        int pv[8];
#pragma unroll
        for (int k = 0; k < 8; ++k) { const int i = i0 + k * NGT; pv[k] = (i < T * 64) ? pos[i >> 6] : 0; }
#pragma unroll
        for (int k = 0; k < 8; ++k) { const int i = i0 + k * NGT;
            if (i < T * 64) { const int d = i & 63;
                const float inv = exp2f(-(float)d * (13.287712379549449f / 64.f));
                const float ang = (float)pv[k] * inv;
                float s, c; sincos_acc((double)ang, s, c);
                rot[i] = (f32x2){c, s}; } }
    }
    GAS float* lut = (GAS float*)(F.ws + WS_TAB);
    for (int i = gt; i < 129 * 8; i += NGT) {
        const int n = i >> 3, h = i & 7;
        int bucket;
        if (n < 16) bucket = n;
        else { const int lg = 16 + (int)(logf((float)n / 16.f) / 2.0794415416798357f * 16.f); bucket = lg < 31 ? lg : 31; }
        lut[i] = A.in[I_RELB][bucket * 8 + h] * 1.4426950408889634f;
    }
    const int gw = F.vcu * NWAVES + F.wave, NGW = F.G * NWAVES;
    { int m = gw; for (; m + (RB - 1) * NGW < TMEM; m += RB * NGW) f32rows_to_bf<RB>(A.in[I_MEM] + (size_t)m * DM, (size_t)NGW * DM, (bf16*)(F.ws + WS_MEMN) + (size_t)m * DM, (float*)(F.ws + WS_RSM) + m, (size_t)NGW, F.lane);
      for (; m < TMEM; m += NGW) f32rows_to_bf<1>(A.in[I_MEM] + (size_t)m * DM, 0, (bf16*)(F.ws + WS_MEMN) + (size_t)m * DM, (float*)(F.ws + WS_RSM) + m, 0, F.lane); }
    { int m = gw; for (; m + (RB - 1) * NGW < T; m += RB * NGW) f32rows_to_bf<RB>(A.in[I_X] + (size_t)m * DM, (size_t)NGW * DM, (bf16*)(F.ws + WS_XB) + (size_t)m * DM, (float*)(F.ws + WS_RS) + m, (size_t)NGW, F.lane);
      for (; m < T; m += NGW) f32rows_to_bf<1>(A.in[I_X] + (size_t)m * DM, 0, (bf16*)(F.ws + WS_XB) + (size_t)m * DM, (float*)(F.ws + WS_RS) + m, 0, F.lane); }
}

__device__ __forceinline__ float silu_f(float x) { return x / (1.f + __expf(-x)); }
__device__ __forceinline__ float diff_lambda(Frame& F, const Args& A, int l, float lam_init) {
    const int d = F.lane;
    const float a = wave_sum(A.in[I_LQ1][l * 64 + d] * A.in[I_LK1][l * 64 + d]), b = wave_sum(A.in[I_LQ2][l * 64 + d] * A.in[I_LK2][l * 64 + d]);
    return expf(a) - expf(b) + lam_init;
}
__device__ __forceinline__ void diff_phase(Frame& F, const Args& A, int l, int qslot) {
    const bf16* proj = (const bf16*)(F.ws + WS_PROJ); bf16* mixed = (bf16*)(F.ws + WS_MIXED);
    const float* lut = (const float*)(F.ws + WS_TAB); const int* pos = (const int*)A.in[I_POS];
    const float lam_init = 0.8f - 0.6f * expf(-0.3f * (float)l);
    const float lam = diff_lambda(F, A, l, lam_init);
    volatile LAS int* slot = (volatile LAS int*)(F.MISC + 16);
    const int xcd = (int)(xb_xcc_id() & 7u);
    for (int kq = 0; kq < 8; ++kq) {
      const int yq = (xcd + kq) & 7;
      gu32* qhead = F.ctl + CW_QUEUE + 64 * (qslot * 8 + yq);
      unsigned nextu = 0;
      if (threadIdx.x == 0) nextu = __hip_atomic_fetch_add(qhead, 1u, RLX_AGENT);
      for (;;) {
        if (threadIdx.x == 0) *slot = (int)nextu;
        __syncthreads();
        const int u = __builtin_amdgcn_readfirstlane(*slot);
        __syncthreads();
        if (u >= 16 * 16) break;
        if (threadIdx.x == 0) nextu = __hip_atomic_fetch_add(qhead, 1u, RLX_AGENT);
        const int qb = 15 - (u >> 4), bh = yq * 16 + (u & 15), b = bh >> 3, h = bh & 7;
        at16::Unit U;
        const bf16* dsec = (const bf16*)(F.ws + WS_DSEC) + (size_t)(b * 8 + h) * SEQ * 128;
        U.Q = dsec + (size_t)(qb * 128) * 128; U.ldq = 128;
        U.K = dsec + (size_t)T * 1024; U.ldk = 128;
        U.V = dsec + 2 * (size_t)T * 1024; U.ldv = 128;
        U.NT = 2 * (qb + 1); U.posq = pos + b * SEQ + qb * 128; U.posk = pos + b * SEQ; U.lut = lut + h; U.lut_stride = 8; U.q0 = qb * 128;
        at16::f32x4 o[2][8]; float inv[2][4];
        at16::run<2, 2, true>(U, F.lds + RING_OFF, o, inv);
        int te_ = threadIdx.x; asm volatile("" : "+v"(te_));
        const int i = te_ & 15, g = (te_ >> 4) & 3, wv = __builtin_amdgcn_readfirstlane(te_ >> 6);
        float ss[4] = {0.f, 0.f, 0.f, 0.f};
        float gs[8];
#pragma unroll
        for (int d = 0; d < 8; ++d) gs[d] = A.in[I_GSUB][l * 128 + 16 * d + i] * (1.f - lam_init);
#pragma unroll
        for (int d = 0; d < 8; ++d)
#pragma unroll
            for (int r = 0; r < 4; ++r) { const float v = o[0][d][r] * inv[0][r] - lam * (o[1][d][r] * inv[1][r]); o[0][d][r] = v; ss[r] += v * v; }
        LAS unsigned char* ob = F.lds + RING_OFF;
#pragma unroll
        for (int r = 0; r < 4; ++r) {
            { float v_ = ss[r]; v_ += WS_DPP(v_, 0xB1); v_ += WS_DPP(v_, 0x4E); v_ += WS_DPP(v_, 0x124); v_ += WS_DPP(v_, 0x128); ss[r] = v_; }
            const float sc = 1.0f / sqrtf(ss[r] * (1.f / 128.f) + EPS);
#pragma unroll
            for (int d = 0; d < 8; ++d) *(LAS bf16*)(ob + (wv * 16 + 4 * g + r) * 272 + (16 * d + i) * 2) = (bf16)f2bf(o[0][d][r] * sc * gs[d]);
        }
        __syncthreads();
#pragma unroll
        for (int k = 0; k < 4; ++k) { const int idx = te_ + 512 * k, row = idx >> 4, c = idx & 15;
            *(GAS v4u*)(mixed + (size_t)(b * SEQ + qb * 128 + row) * DM + 1024 + h * 128 + c * 8) = *(const LAS v4u*)(ob + row * 272 + c * 16); }
      }
    }
}
__device__ __forceinline__ void xattn_phase(Frame& F, bf16* obuf) {
    bf16* qx = (bf16*)(F.ws + WS_QX); const bf16* kv = (const bf16*)(F.ws + WS_KVX);
    for (int wi = F.vcu; wi < BATCH * X_H * 4; wi += F.G)
#pragma unroll 1
    for (int kk = 0; kk < 4; ++kk) {
        const int qb = 4 * (wi & 3) + kk, h = (wi >> 2) & 3, b = wi >> 4;
        at16::Unit U;
        U.Q = qx + (size_t)(b * SEQ + qb * 128) * XW + h * 128; U.ldq = XW;
        U.K = kv + (size_t)(b * MEMLEN) * 1024 + h * 128; U.ldk = 1024;
        U.V = kv + (size_t)(b * MEMLEN) * 1024 + 512 + h * 128; U.ldv = 1024;
        U.NT = MEMLEN / 64; U.posq = nullptr; U.posk = nullptr; U.lut = nullptr; U.lut_stride = 0; U.q0 = 0;
        at16::f32x4 o[1][8]; float inv[1][4];
        static_assert(MEMLEN / 64 <= 4, "the memory keys must fit the tile ring");
        at16::run<1, 4, false>(U, F.lds + RING_OFF, o, inv, kk > 0);
        int te_ = threadIdx.x; asm volatile("" : "+v"(te_));
        const int i = te_ & 15, g = (te_ >> 4) & 3, wv = __builtin_amdgcn_readfirstlane(te_ >> 6);
#pragma unroll
        for (int r = 0; r < 4; ++r) { bf16* orow = obuf + (size_t)(b * SEQ + qb * 128 + wv * 16 + 4 * g + r) * XW + h * 128 + i;
#pragma unroll
            for (int d = 0; d < 8; ++d) orow[16 * d] = (bf16)f2bf(o[0][d][r] * inv[0][r]); }
    }
}


__device__ __forceinline__ void s5_phase(Frame& F, const Args& A, int l) {
    static_assert(s5f::LDS_NEED <= LDSCTL_OFF, "S5 LDS");
    const bf16* proj = (const bf16*)(F.ws + WS_PROJ); bf16* Gb = (bf16*)(F.ws + WS_G);
    for (int u = F.vcu; u < BATCH * S5_G; u += F.G) {
        int g = u & 31, b = u >> 5;
        if (F.G == 256) { const int jj = (F.vcu & 31) + 32 * (u >> 8); g = 4 * (F.vcu >> 5) + (jj >> 4); b = jj & 15; }
        s5f::unit(proj + (size_t)(b * SEQ) * INWP + C_SU + g * 16, INWP, Gb + (size_t)(b * SEQ) * 512 + g * 16, F.ws + WS_S5C + (size_t)l * (12 * MiB), g, A.in[I_DSKIP] + l * 512 + g * 16, F.lds + RING_OFF);
    }
}
__device__ __forceinline__ void s5_consts_phase(Frame& F, const Args& A, int l) {
    s5f::consts(F.ws + WS_S5C + (size_t)l * (12 * MiB), A.in[I_LAMRE], A.in[I_LAMIM], A.in[I_LOGDT], A.in[I_BRE], A.in[I_BIM], A.in[I_CRE], A.in[I_CIM], l, F.vcu * NWAVES + F.wave, F.G * NWAVES, F.lane);
}


__device__ __forceinline__ void ret_phase(Frame& F) {
    static_assert(retf::LDS_NEED <= LDSCTL_OFF, "retention LDS");
    const bf16* proj = (const bf16*)(F.ws + WS_PROJ); bf16* mixed = (bf16*)(F.ws + WS_MIXED);
    const retf::f32x2* rot = (const retf::f32x2*)(F.ws + WS_ROT);
    const int stride = (F.G >= 256) ? 4 : 1;
    for (int v = F.vcu; v < BATCH * RET_H * stride; v += F.G) {
        if (v % stride) continue;
        const int u = v / stride, h = u & 3, b = u >> 2; const size_t r0 = (size_t)b * SEQ;
        retf::unit(proj + r0 * INWP + C_RQ + h * 128, proj + r0 * INWP + C_RK + h * 128, proj + r0 * INWP + C_RV + h * 128, proj + r0 * INWP + C_RG + h * 128, INWP,
                   rot + r0 * 64, mixed + r0 * DM + h * 128, DM, h, EPS, F.lds + RING_OFF);
    }
}

__global__ void __launch_bounds__(NWAVES * 64, 2) hybrid_fwd(Args A) {
    extern __shared__ __attribute__((aligned(16))) unsigned char lds[];
    Frame F;
    F.lds = (LAS unsigned char*)lds;
    F.MISC = (volatile LAS unsigned*)(F.lds + MISC_OFF);
    F.tid = threadIdx.x; F.lane = F.tid & 63; F.wave = __builtin_amdgcn_readfirstlane(F.tid >> 6);
    F.G = gridDim.x; { const int bx = blockIdx.x; F.vcu = (F.G % 8 == 0) ? (bx % 8) * (F.G / 8) + bx / 8 : bx; }
    unsigned char* ws = A.ws; F.ws = ws; F.out = A.out;
    F.ctl = (gu32*)(ws + WS_CTL);
    for (int u = F.tid; u < (LDS_BYTES - LDSCTL_OFF) / 4; u += NWAVES * 64) ((LAS unsigned*)(F.lds + LDSCTL_OFF))[u] = 0u;
    __syncthreads();
    XcdBarrier bar; bar.bar = (unsigned*)(F.ctl + CW_BAR); bar.x = 0; bar.st = nullptr;
    if (A.use_bar) bar = xcd_barrier_post((unsigned*)(F.ctl + CW_BAR), F.MISC + 8);
    const int lo = A.ph_lo, hi = A.ph_hi;
#ifndef PHMASK
#define PHMASK 0xffff
#endif
#define PHON(k) (((PHMASK) >> (k)) & 1)
#ifndef PHREP
#define PHREP 0
#endif
#define NREP(k) ((((PHREP) >> (k)) & 1) ? 2 : 1)
#define REPLOOP(k) _Pragma("unroll 1") for (int rep = 0; rep < NREP(k); ++rep)
#define REPLAST(k) (rep == NREP(k) - 1)
#define IN(k) (lo <= (k) && (k) < hi)
#define RELAUNDER() do { int t_ = threadIdx.x; asm volatile("" : "+v"(t_)); F.tid = t_; F.lane = t_ & 63; F.wave = __builtin_amdgcn_readfirstlane(t_ >> 6); asm volatile("" : "+s"(F.vcu)); } while (0)
#ifndef SEAM_REP
#define SEAM_REP 1
#endif
#define SEAM(k) do { if (IN((k) + 1)) { _Pragma("unroll 1") for (int sr_ = 0; sr_ < SEAM_REP; ++sr_) xcd_barrier(bar); } } while (0)

    bf16* const XB = (bf16*)(ws + WS_XB); float* const RS = (float*)(ws + WS_RS); bf16* const Yb = (bf16*)(ws + WS_Y); bf16* const PROJ = (bf16*)(ws + WS_PROJ); bf16* const MIXED = (bf16*)(ws + WS_MIXED);
    bf16* const Gb = (bf16*)(ws + WS_G); bf16* const QX = (bf16*)(ws + WS_QX); bf16* const KVX = (bf16*)(ws + WS_KVX); bf16* const MEMN = (bf16*)(ws + WS_MEMN); bf16* const HID = PROJ;

    if (PHON(15) && IN(0)) { RELAUNDER();
        REPLOOP(15) {
        convert_weights(F, A, 0, F.vcu * NWAVES + F.wave, F.G * NWAVES, 0, 1);
#pragma unroll 1
        for (int ll = 0; ll < DEPTH; ++ll) s5_consts_phase(F, A, ll);
        prologue_misc(F, A);
        }
        SEAM(0);
    }
#pragma unroll 1
    for (int l = 0; l < DEPTH; ++l) {
        const int pb = 1 + l * NPH_LAYER;
        unsigned char* const wl = ws + (size_t)l * WS_WL1;
        if (PHON(0) && IN(pb + 0)) { RELAUNDER();
            REPLOOP(0) {
            pg8::Gemm g{XB, (const bf16*)(wl + WS_WIN), T, INW, DM}; pg8::StaticOrder S; S.init(T, INW, F.G, launder_s((int)blockIdx.x));
            pg8::EpiB<0> E{PROJ, INWP, 0.18033688011112042f, nullptr, 0, C_DQ / 256, C_DK / 256, RS, (bf16*)(ws + WS_DSEC), C_DQ / 256, 0};
            pg8::gemm_phase<pg8::EpiB<0>, pg8::StaticOrder, PG8_ALIGN, PG8_SP2>(F.lds + RING_OFF, g, S, E);
            }
            SEAM(pb + 0);
        }
        if (PHON(1) && IN(pb + 1)) { RELAUNDER();
            REPLOOP(16) { pg8::Gemm g{MEMN, (const bf16*)(wl + WS_WXKV), TMEM, 2 * XW, DM}; pg8::StaticOrder S; S.init(TMEM, 2 * XW, F.G, launder_s((int)blockIdx.x));
              pg8::EpiB<0> E{KVX, 2 * XW, 1.f, nullptr, 0, 0, 0, (const float*)(ws + WS_RSM), nullptr, 0, 0};
              pg8::gemm_phase<pg8::EpiB<0>, pg8::StaticOrder, PG8_ALIGN, PG8_SP2>(F.lds + RING_OFF, g, S, E); }
            REPLOOP(17) s5_phase(F, A, l);
            REPLOOP(18) ret_phase(F);
            REPLOOP(19) diff_phase(F, A, l, l * 2 + rep);
            SEAM(pb + 1);
        }
        if (PHON(2) && IN(pb + 2)) { RELAUNDER();
            REPLOOP(2) {
            pg8::Gemm g{Gb, (const bf16*)(wl + WS_WGLU), T, 512, 512}; pg8::StaticOrder S; S.init(T, 512, F.G, launder_s((int)blockIdx.x));
            pg8::EpiB<3> E{MIXED + 512, DM, 1.f, Gb, 512, 0, 0, nullptr, nullptr, 0, 0};
            pg8::gemm_phase<pg8::EpiB<3>, pg8::StaticOrder, PG8_ALIGN, PG8_SP2>(F.lds + RING_OFF, g, S, E);
            }
            SEAM(pb + 2);
        }
        if (PHON(3) && IN(pb + 3)) { RELAUNDER();
            REPLOOP(3) {
            pg8::Gemm g{MIXED, (const bf16*)(wl + WS_WOUT), T, DM, DM}; pg8::StaticOrder S; S.init(T, DM, F.G, launder_s((int)blockIdx.x));
            pg8::EpiB<0> E{Yb, DM, 1.f, nullptr, 0, 0, 0, nullptr, nullptr, 0, 0};
            pg8::gemm_phase<pg8::EpiB<0>, pg8::StaticOrder, PG8_ALIGN, PG8_SP2>(F.lds + RING_OFF, g, S, E);
            }
            SEAM(pb + 3);
        }
        if (PHON(4) && IN(pb + 4)) { RELAUNDER();
            REPLOOP(4) {
            resnorm_phase(F, XB, Yb, A.in[I_GMIXPOST] + l * DM, REPLAST(4) ? XB : PROJ, RS, nullptr);
            }
            SEAM(pb + 4);
        }
        if (PHON(5) && IN(pb + 5)) { RELAUNDER();
            REPLOOP(5) {
            pg8::Gemm g{XB, (const bf16*)(wl + WS_WXQ), T, XW, DM}; pg8::StaticOrder S; S.init(T, XW, F.G, launder_s((int)blockIdx.x));
            pg8::EpiB<0> E{QX, XW, 0.12751743082459868f, nullptr, 0, 0, 2, RS, nullptr, 0, 0};
            pg8::gemm_phase<pg8::EpiB<0>, pg8::StaticOrder, PG8_ALIGN, PG8_SP2>(F.lds + RING_OFF, g, S, E);
            }
            SEAM(pb + 5);
        }
        if (PHON(6) && IN(pb + 6)) { RELAUNDER();
            REPLOOP(6) {
            xattn_phase(F, REPLAST(6) ? QX : Gb);
            }
            SEAM(pb + 6);
        }
        if (PHON(7) && IN(pb + 7)) { RELAUNDER();
            REPLOOP(7) {
            pg8::Gemm g{QX, (const bf16*)(wl + WS_WXO), T, DM, XW}; pg8::StaticOrder S; S.init(T, DM, F.G, launder_s((int)blockIdx.x));
            pg8::EpiB<0> E{Yb, DM, 1.f, nullptr, 0, 0, 0, nullptr, nullptr, 0, 0};
            pg8::gemm_phase<pg8::EpiB<0>, pg8::StaticOrder, PG8_ALIGN, PG8_SP2>(F.lds + RING_OFF, g, S, E);
            }
            SEAM(pb + 7);
        }
        if (PHON(8) && IN(pb + 8)) { RELAUNDER();
            REPLOOP(8) {
            resnorm_phase(F, XB, Yb, A.in[I_GXPOST] + l * DM, REPLAST(8) ? XB : PROJ, RS, nullptr);
            }
            SEAM(pb + 8);
        }
#pragma unroll 1
        for (int st = 0; st <= MLP_SPLIT; ++st) {
            if (IN(pb + 9 + st)) { RELAUNDER();
            bf16* const hid_dn = ((st - 1) & 1) ? MIXED : HID; bf16* const hid_up = (st & 1) ? MIXED : HID;
            if (PHON(10) && st > 0) { const int hf = st - 1;
            REPLOOP(10) {
                pg8::Gemm g{hid_dn, (const bf16*)(wl + WS_WDN), MLP_ROWS, DM, DFF}; pg8::StaticOrder S; S.init(MLP_ROWS, DM, F.G, launder_s((int)blockIdx.x));
                pg8::EpiB<0> E{Yb + (size_t)hf * MLP_ROWS * DM, DM, 1.f, nullptr, 0, 0, 0, nullptr, nullptr, 0, 0};
                pg8::gemm_phase<pg8::EpiB<0>, pg8::StaticOrder, PG8_ALIGN, PG8_SP2, true>(F.lds + RING_OFF, g, S, E);
            } }
            if (PHON(9) && st < MLP_SPLIT) { const int hf = st;
            REPLOOP(9) {
                pg8::Gemm g{XB + (size_t)hf * MLP_ROWS * DM, (const bf16*)(wl + WS_WUP), MLP_ROWS, DFF, DM}; pg8::StaticOrder S; S.init(MLP_ROWS, DFF, F.G, launder_s((int)blockIdx.x));
                pg8::EpiB<2> E{hid_up, DFF, 1.f, nullptr, 0, 0, 0, RS + (size_t)hf * MLP_ROWS, nullptr, 0, 1};
                pg8::gemm_phase<pg8::EpiB<2>, pg8::StaticOrder, PG8_ALIGN, PG8_SP2>(F.lds + RING_OFF, g, S, E);
            } }
            SEAM(pb + 9 + st);
            }
        }
        if (PHON(13) && IN(pb + 10 + MLP_SPLIT)) { RELAUNDER();
            REPLOOP(13) {
            if (l + 1 < DEPTH) resnorm_phase(F, XB, Yb, A.in[I_GMLPPOST] + l * DM, REPLAST(13) ? XB : PROJ, RS, nullptr);
            else resnorm_phase(F, XB, Yb, A.in[I_GMLPPOST] + l * DM, nullptr, nullptr, F.out);
            if (l + 1 < DEPTH) convert_weights(F, A, l + 1, F.vcu * NWAVES + F.wave, F.G * NWAVES, 0, 1);
            }
            SEAM(pb + 10 + MLP_SPLIT);
        }
    }
#undef IN
#undef SEAM
}

extern "C" void kernel_launch(void* const* d_in, const int* in_sizes, int n_in, void* d_out, int out_size, void* d_ws, size_t ws_size, hipStream_t stream) {
    static int grid = 0;
    if (grid == 0) {
        if (n_in != 32 || in_sizes[0] != T * DM || out_size != T * DM || ws_size < WS_END) { fprintf(stderr, "kernel_launch: shape mismatch (n_in %d, in0 %d, out %d, ws %zu, need %zu); nothing launched\n", n_in, n_in > 0 ? in_sizes[0] : -1, out_size, ws_size, (size_t)WS_END); grid = -1; return; }
        int dev = 0, cus = 0, per_cu = 0;
        if (hipGetDevice(&dev) != hipSuccess || hipDeviceGetAttribute(&cus, hipDeviceAttributeMultiprocessorCount, dev) != hipSuccess) { grid = -1; return; }
        if (hipFuncSetAttribute((const void*)hybrid_fwd, hipFuncAttributeMaxDynamicSharedMemorySize, LDS_BYTES) != hipSuccess) { fprintf(stderr, "kernel_launch: hipFuncSetAttribute failed\n"); grid = -1; return; }
        if (hipOccupancyMaxActiveBlocksPerMultiprocessor(&per_cu, (const void*)hybrid_fwd, NWAVES * 64, LDS_BYTES) != hipSuccess || per_cu < 1) { fprintf(stderr, "kernel_launch: occupancy query says %d blocks per CU\n", per_cu); }
        (void)hipGetLastError();
        grid = cus;
    }
    if (grid < 0) return;
    if (hipMemsetAsync((char*)d_ws + WS_CTL, 0, CTL_ZERO_BYTES, stream) != hipSuccess) return;
    Args a{};
    for (int i = 0; i < 32; ++i) a.in[i] = (const float*)d_in[i];
    a.out = (float*)d_out; a.ws = (unsigned char*)d_ws; a.pad = 0;
#if MK_ONE_LAUNCH
    a.ph_lo = 0; a.ph_hi = NPHASES; a.use_bar = 1;
    hipLaunchKernelGGL(hybrid_fwd, dim3(grid), dim3(NWAVES * 64), LDS_BYTES, stream, a);
#else
    for (int p = 0; p < NPHASES; ++p) { a.ph_lo = p; a.ph_hi = p + 1; a.use_bar = 0;
        hipLaunchKernelGGL(hybrid_fwd, dim3(grid), dim3(NWAVES * 64), LDS_BYTES, stream, a); }
#endif
    const hipError_t le = hipPeekAtLastError();
    if (le != hipSuccess) fprintf(stderr, "kernel_launch: launch failed: %s\n", hipGetErrorName(le));
}
```
